# Optimizing an MI355X kernel written in HIP

```python
import math
import jax, jax.numpy as jnp
from jax import lax
import numpy as np


D_MODEL = 1024
BATCH = 16
SEQ = 2048
DEPTH = 2

N_META = 16
MLA_HEADS = 8
MLA_NOPE = 64
MLA_ROPE = 32
MLA_V = 64
MLA_Q_RANK = 256
MLA_KV_RANK = 256
ROPE_THETA = 10000.0
Q_BLOCK = 128
MASK_VALUE = -1e9
S5_WIDTH = 512
S5_GROUP = 16
S5_GROUPS = S5_WIDTH // S5_GROUP
S5_STATE = 64
S5_DT_MIN = 1e-3
S5_DT_MAX = 1e-1
HG_HEADS = 4
HG_KEY = 128
HG_VAL = 128
HG_CHUNK = 64
HG_QK = HG_HEADS * HG_KEY
HG_VW = HG_HEADS * HG_VAL
HG_F_MIN = 1e-6
N_BRANCH = 3
D_FF = -(-(8 * D_MODEL) // (3 * 256)) * 256
ALPHA = (2 * DEPTH) ** 0.25
BETA = (8 * DEPTH) ** -0.25
MLA_IN = MLA_Q_RANK + MLA_KV_RANK + MLA_ROPE
S5_IN = S5_WIDTH
HG_IN = 2 * HG_QK + 2 * HG_VW
GATE_IN = N_BRANCH * D_MODEL
D_IN = MLA_IN + S5_IN + HG_IN + GATE_IN
SPLIT_IN = [MLA_IN, MLA_IN + S5_IN, MLA_IN + S5_IN + HG_IN]

kernel_name = 'hybrid_mla_s5_hgrn2_deepnorm_meta'


def layer_norm(x, g, b, eps=1e-5):
    xf = x.astype(jnp.float32)
    mu = jnp.mean(xf, axis=-1, keepdims=True)
    var = jnp.mean(jnp.square(xf - mu), axis=-1, keepdims=True)
    return ((xf - mu) * lax.rsqrt(var + eps) * g.astype(jnp.float32) + b.astype(jnp.float32)).astype(x.dtype)


def rms_norm(x, g, eps=1e-6):
    xf = x.astype(jnp.float32)
    return (xf * lax.rsqrt(jnp.mean(jnp.square(xf), axis=-1, keepdims=True) + eps) * g.astype(jnp.float32)).astype(x.dtype)


def rope_tables(pos):
    inv = ROPE_THETA ** (-(jnp.arange(0, MLA_ROPE, 2, dtype=jnp.float32) / MLA_ROPE))
    ang = pos.astype(jnp.float32)[..., None] * inv
    return jnp.cos(ang), jnp.sin(ang)


def apply_rope(x, cos, sin):
    x1, x2 = jnp.split(x.astype(jnp.float32), 2, axis=-1)
    return jnp.concatenate([x1 * cos - x2 * sin, x1 * sin + x2 * cos], axis=-1).astype(x.dtype)


def mla_mixer(z, cos, sin, q_norm, w_uq, kv_norm, w_ukv):
    B_, L_, _ = z.shape
    c_q, c_kv, k_r = jnp.split(z, [MLA_Q_RANK, MLA_Q_RANK + MLA_KV_RANK], axis=-1)
    q = (rms_norm(c_q, q_norm) @ w_uq).reshape(B_, L_, MLA_HEADS, MLA_NOPE + MLA_ROPE)
    q_nope, q_rope = jnp.split(q, [MLA_NOPE], axis=-1)
    q_rope = apply_rope(q_rope, cos[:, :, None, :], sin[:, :, None, :])
    kv = (rms_norm(c_kv, kv_norm) @ w_ukv).reshape(B_, L_, MLA_HEADS, MLA_NOPE + MLA_V)
    k_nope, v = jnp.split(kv, [MLA_NOPE], axis=-1)
    k_rope = apply_rope(k_r, cos, sin)
    scale = (MLA_NOPE + MLA_ROPE) ** -0.5
    key_idx = jnp.arange(L_)

    def attend(qn, qr, q_start):
        s = (jnp.einsum('bqhd,bkhd->bhqk', qn, k_nope) + jnp.einsum('bqhr,bkr->bhqk', qr, k_rope)).astype(jnp.float32) * scale
        q_idx = q_start + jnp.arange(qn.shape[1])
        s = jnp.where(key_idx[None, :] <= q_idx[:, None], s, MASK_VALUE)
        p = jax.nn.softmax(s, axis=-1).astype(v.dtype)
        return jnp.einsum('bhqk,bkhd->bqhd', p, v)

    o_meta = attend(q_nope[:, :N_META], q_rope[:, :N_META], 0).reshape(B_, N_META, MLA_HEADS * MLA_V)
    n_blk = (L_ - N_META) // Q_BLOCK

    def blocks(t):
        return t[:, N_META:].reshape((B_, n_blk, Q_BLOCK) + t.shape[2:]).swapaxes(0, 1)

    starts = N_META + Q_BLOCK * jnp.arange(n_blk, dtype=jnp.int32)
    o_real = lax.map(lambda a: attend(a[0], a[1], a[2]), (blocks(q_nope), blocks(q_rope), starts))
    o_real = o_real.swapaxes(0, 1).reshape(B_, L_ - N_META, MLA_HEADS * MLA_V)
    return jnp.concatenate([o_meta, o_real], axis=1)


def s5_mixer(u, lam_re, lam_im, log_dt, b_re, b_im, c_re, c_im, d_skip, w_glu):
    f32 = jnp.float32
    B_, L_, _ = u.shape
    lr = jnp.minimum(lam_re.astype(f32), -1e-4)
    li = lam_im.astype(f32)
    dt = jnp.exp(log_dt.astype(f32))[:, None]
    mag = jnp.exp(lr * dt)
    ab_r = mag * jnp.cos(li * dt)
    ab_i = mag * jnp.sin(li * dt)
    den = lr * lr + li * li
    nr = ab_r - 1.0
    coef_r = ((nr * lr + ab_i * li) / den)[..., None]
    coef_i = ((ab_i * lr - nr * li) / den)[..., None]
    bb_r = coef_r * b_re.astype(f32) - coef_i * b_im.astype(f32)
    bb_i = coef_r * b_im.astype(f32) + coef_i * b_re.astype(f32)
    uf = u.astype(f32)
    ug = uf.reshape(B_, L_, S5_GROUPS, S5_GROUP)
    bu_r = jnp.einsum('blgc,gnc->blgn', ug, bb_r)
    bu_i = jnp.einsum('blgc,gnc->blgn', ug, bb_i)
    a_r = jnp.broadcast_to(ab_r[None, None], (1, L_, S5_GROUPS, S5_STATE))
    a_i = jnp.broadcast_to(ab_i[None, None], (1, L_, S5_GROUPS, S5_STATE))

    def combine(e1, e2):
        a1r, a1i, b1r, b1i = e1
        a2r, a2i, b2r, b2i = e2
        return (a2r * a1r - a2i * a1i, a2r * a1i + a2i * a1r,
                a2r * b1r - a2i * b1i + b2r, a2r * b1i + a2i * b1r + b2i)

    _, _, x_r, x_i = lax.associative_scan(combine, (a_r, a_i, bu_r, bu_i), axis=1)
    y = jnp.einsum('blgn,gcn->blgc', x_r, c_re.astype(f32)) - jnp.einsum('blgn,gcn->blgc', x_i, c_im.astype(f32))
    y = y.reshape(B_, L_, S5_WIDTH) + d_skip.astype(f32) * uf
    y = jax.nn.gelu(y)
    y = y * jax.nn.sigmoid(y @ w_glu.astype(f32))
    return y.astype(u.dtype)


def hgrn2_chunk(state, q, k, v, log_f):
    cum = jnp.cumsum(log_f, axis=2)
    n = q.shape[2]
    causal = jnp.tril(jnp.ones((n, n), dtype=bool))[None, None, :, :, None]
    rel = cum[:, :, :, None, :] - cum[:, :, None, :, :]
    decay = jnp.where(causal, jnp.exp(jnp.minimum(rel, 0.0)), 0.0)
    scores = jnp.einsum('bhtk,bhsk,bhtsk->bhts', q, k, decay)
    out = jnp.einsum('bhts,bhsv->bhtv', scores, v) + jnp.einsum('bhtk,bhkv->bhtv', q * jnp.exp(cum), state)
    last = cum[:, :, -1:, :]
    new_state = jnp.exp(last[:, :, 0, :, None]) * state + jnp.einsum('bhsk,bhsv->bhkv', k * jnp.exp(last - cum), v)
    return new_state, out


def hgrn2_mixer(z, lb, out_norm):
    f32 = jnp.float32
    B_, L_, _ = z.shape
    q, zf, v, g = jnp.split(z.astype(f32), [HG_QK, 2 * HG_QK, 2 * HG_QK + HG_VW], axis=-1)
    lb = lb.astype(f32)
    f = lb + (1.0 - lb) * jax.nn.sigmoid(zf)
    log_f = jnp.log(jnp.maximum(f, HG_F_MIN))
    k = (1.0 - lb) * jax.nn.sigmoid(-zf)

    def heads(t, d):
        return t.reshape(B_, L_, HG_HEADS, d).transpose(0, 2, 1, 3)

    q, k, log_f, v = heads(q, HG_KEY), heads(k, HG_KEY), heads(log_f, HG_KEY), heads(v, HG_VAL)
    s0 = jnp.zeros((B_, HG_HEADS, HG_KEY, HG_VAL), f32)
    s_meta, o_meta = hgrn2_chunk(s0, q[:, :, :N_META], k[:, :, :N_META], v[:, :, :N_META], log_f[:, :, :N_META])
    n_chunks = (L_ - N_META) // HG_CHUNK

    def to_chunks(t):
        return t[:, :, N_META:].reshape(B_, HG_HEADS, n_chunks, HG_CHUNK, t.shape[-1]).transpose(2, 0, 1, 3, 4)

    def step(s, xs):
        return hgrn2_chunk(s, xs[0], xs[1], xs[2], xs[3])

    _, o_real = lax.scan(step, s_meta, (to_chunks(q), to_chunks(k), to_chunks(v), to_chunks(log_f)))
    o_real = o_real.transpose(1, 2, 0, 3, 4).reshape(B_, HG_HEADS, L_ - N_META, HG_VAL)
    o = jnp.concatenate([o_meta, o_real], axis=2).transpose(0, 2, 1, 3)
    o = rms_norm(o, out_norm.reshape(HG_HEADS, HG_VAL))
    return (o.reshape(B_, L_, HG_VW) * jax.nn.silu(g)).astype(z.dtype)


def setup_inputs(seed: int = 0) -> dict:
    key = jax.random.key(seed)
    ks = iter(jax.random.split(key, 40))
    f32 = jnp.float32

    def nrm(shape, scale):
        return scale * jax.random.normal(next(ks), shape, f32)

    def gain(shape):
        return 1.0 + nrm(shape, 0.02)

    L = DEPTH
    x = nrm((BATCH, SEQ, D_MODEL), 1.0)
    positions = jnp.broadcast_to(jnp.arange(SEQ, dtype=jnp.int32)[None], (BATCH, SEQ))
    meta_tokens = nrm((N_META, D_MODEL), 1.0)
    ln_in_g = gain((D_MODEL,))
    ln_in_b = nrm((D_MODEL,), 0.02)
    w_in = nrm((L, D_MODEL, D_IN), D_MODEL ** -0.5)
    mla_q_norm = gain((L, MLA_Q_RANK))
    mla_w_uq = nrm((L, MLA_Q_RANK, MLA_HEADS * (MLA_NOPE + MLA_ROPE)), MLA_Q_RANK ** -0.5)
    mla_kv_norm = gain((L, MLA_KV_RANK))
    mla_w_ukv = nrm((L, MLA_KV_RANK, MLA_HEADS * (MLA_NOPE + MLA_V)), MLA_KV_RANK ** -0.5)
    s5_lam_re = -0.5 + nrm((L, S5_GROUPS, S5_STATE), 0.01)
    s5_lam_im = jnp.pi * jnp.arange(S5_STATE, dtype=f32)[None, None, :] + nrm((L, S5_GROUPS, S5_STATE), 0.01)
    s5_log_dt = jax.random.uniform(next(ks), (L, S5_GROUPS), f32, math.log(S5_DT_MIN), math.log(S5_DT_MAX))
    s5_b_re = nrm((L, S5_GROUPS, S5_STATE, S5_GROUP), (2 * S5_GROUP) ** -0.5)
    s5_b_im = nrm((L, S5_GROUPS, S5_STATE, S5_GROUP), (2 * S5_GROUP) ** -0.5)
    s5_c_re = nrm((L, S5_GROUPS, S5_GROUP, S5_STATE), S5_STATE ** -0.5)
    s5_c_im = nrm((L, S5_GROUPS, S5_GROUP, S5_STATE), S5_STATE ** -0.5)
    s5_d = nrm((L, S5_WIDTH), 1.0)
    s5_w_glu = nrm((L, S5_WIDTH, S5_WIDTH), S5_WIDTH ** -0.5)
    hg_lb_logits = nrm((L, HG_QK), 0.1)
    hg_out_norm = gain((L, HG_VW))
    w_br_mla = nrm((L, MLA_HEADS * MLA_V, D_MODEL), BETA * (MLA_HEADS * MLA_V) ** -0.5)
    w_br_s5 = nrm((L, S5_WIDTH, D_MODEL), BETA * S5_WIDTH ** -0.5)
    w_br_hg = nrm((L, HG_VW, D_MODEL), BETA * HG_VW ** -0.5)
    w_out = nrm((L, D_MODEL, D_MODEL), BETA * D_MODEL ** -0.5)
    ln1_g = gain((L, D_MODEL))
    ln1_b = nrm((L, D_MODEL), 0.02)
    w_ffn_gate = nrm((L, D_MODEL, D_FF), D_MODEL ** -0.5)
    w_ffn_up = nrm((L, D_MODEL, D_FF), D_MODEL ** -0.5)
    w_ffn_down = nrm((L, D_FF, D_MODEL), BETA * D_FF ** -0.5)
    ln2_g = gain((L, D_MODEL))
    ln2_b = nrm((L, D_MODEL), 0.02)
    return {'x': x, 'positions': positions, 'meta_tokens': meta_tokens,
            'ln_in_g': ln_in_g, 'ln_in_b': ln_in_b, 'w_in': w_in,
            'mla_q_norm': mla_q_norm, 'mla_w_uq': mla_w_uq, 'mla_kv_norm': mla_kv_norm, 'mla_w_ukv': mla_w_ukv,
            's5_lam_re': s5_lam_re, 's5_lam_im': s5_lam_im, 's5_log_dt': s5_log_dt,
            's5_b_re': s5_b_re, 's5_b_im': s5_b_im, 's5_c_re': s5_c_re, 's5_c_im': s5_c_im,
            's5_d': s5_d, 's5_w_glu': s5_w_glu,
            'hg_lb_logits': hg_lb_logits, 'hg_out_norm': hg_out_norm,
            'w_br_mla': w_br_mla, 'w_br_s5': w_br_s5, 'w_br_hg': w_br_hg, 'w_out': w_out,
            'ln1_g': ln1_g, 'ln1_b': ln1_b,
            'w_ffn_gate': w_ffn_gate, 'w_ffn_up': w_ffn_up, 'w_ffn_down': w_ffn_down,
            'ln2_g': ln2_g, 'ln2_b': ln2_b}


def reference(x, positions, meta_tokens, ln_in_g, ln_in_b, w_in,
              mla_q_norm, mla_w_uq, mla_kv_norm, mla_w_ukv,
              s5_lam_re, s5_lam_im, s5_log_dt, s5_b_re, s5_b_im, s5_c_re, s5_c_im, s5_d, s5_w_glu,
              hg_lb_logits, hg_out_norm,
              w_br_mla, w_br_s5, w_br_hg, w_out, ln1_g, ln1_b,
              w_ffn_gate, w_ffn_up, w_ffn_down, ln2_g, ln2_b):
    B_ = x.shape[0]
    meta = jnp.broadcast_to(meta_tokens.astype(x.dtype)[None], (B_, N_META, D_MODEL))
    h = layer_norm(jnp.concatenate([meta, x], axis=1), ln_in_g, ln_in_b)
    meta_pos = jnp.broadcast_to(jnp.arange(N_META, dtype=jnp.int32)[None], (B_, N_META))
    pos = jnp.concatenate([meta_pos, positions.astype(jnp.int32) + N_META], axis=1)
    cos, sin = rope_tables(pos)
    p_lb = jax.nn.softmax(hg_lb_logits.astype(jnp.float32), axis=0)
    lower_bounds = jnp.cumsum(p_lb, axis=0) - p_lb[0]
    for l in range(DEPTH):
        z = h @ w_in[l]
        z_mla, z_s5, z_hg, z_gate = jnp.split(z, SPLIT_IN, axis=-1)
        y_mla = mla_mixer(z_mla, cos, sin, mla_q_norm[l], mla_w_uq[l], mla_kv_norm[l], mla_w_ukv[l]) @ w_br_mla[l]
        y_s5 = s5_mixer(z_s5, s5_lam_re[l], s5_lam_im[l], s5_log_dt[l], s5_b_re[l], s5_b_im[l],
                        s5_c_re[l], s5_c_im[l], s5_d[l], s5_w_glu[l]) @ w_br_s5[l]
        y_hg = hgrn2_mixer(z_hg, lower_bounds[l], hg_out_norm[l]) @ w_br_hg[l]
        g_mla, g_s5, g_hg = jnp.split(jax.nn.sigmoid(z_gate), N_BRANCH, axis=-1)
        mixed = (g_mla * y_mla + g_s5 * y_s5 + g_hg * y_hg) @ w_out[l]
        h = layer_norm(ALPHA * h + mixed, ln1_g[l], ln1_b[l])
        ffn = (jax.nn.silu(h @ w_ffn_gate[l]) * (h @ w_ffn_up[l])) @ w_ffn_down[l]
        h = layer_norm(ALPHA * h + ffn, ln2_g[l], ln2_b[l])
    return h[:, N_META:]
```

```cpp
#include <hip/hip_runtime.h>
#include <hip/hip_cooperative_groups.h>
#include <cstdint>
#include <cstdio>
namespace cg = cooperative_groups;
#ifndef DBL_C
#define DBL_C 0
#endif
#ifndef DBL_HG
#define DBL_HG 0
#endif
#ifndef PH_PRO
#define PH_PRO 1
#endif
#ifndef PH_A
#define PH_A 1
#endif
#ifndef PH_B
#define PH_B 1
#endif
#ifndef PH_C
#define PH_C 1
#endif
#ifndef PH_D
#define PH_D 1
#endif
#ifndef PH_HG1
#define PH_HG1 1
#endif
#ifndef PH_E
#define PH_E 1
#endif
#ifndef PH_HG3
#define PH_HG3 1
#endif
#ifndef PH_F
#define PH_F 1
#endif
#ifndef PH_G
#define PH_G 1
#endif
#ifndef PH_I
#define PH_I 1
#endif
#ifndef PH_J
#define PH_J 1
#endif

#define DI __device__ __forceinline__
#define LAS __attribute__((address_space(3)))
typedef unsigned short bf16_t;
typedef short bf16x8 __attribute__((ext_vector_type(8)));
typedef float f32x4 __attribute__((ext_vector_type(4)));
typedef float f32x2 __attribute__((ext_vector_type(2)));
typedef float f32x16 __attribute__((ext_vector_type(16)));
typedef unsigned u32x4 __attribute__((ext_vector_type(4)));
typedef unsigned u32x2 __attribute__((ext_vector_type(2)));
typedef __bf16 bfv2 __attribute__((ext_vector_type(2)));

constexpr int NB = 16, LSEQ = 2064, T = NB * LSEQ, DM = 1024, DFF = 2816;
constexpr int NCHK = 129;
constexpr int SROWS = 2304;
constexpr int HGC = 33;
constexpr float ALPHA = 1.41421356237309515f;
constexpr float QSCALE = 0.10206207261596575f * 1.4426950408889634f;

constexpr size_t al256(size_t x) { return (x + 255) & ~(size_t)255; }
constexpr size_t W_WIN = 0;
constexpr size_t W_WGATE = W_WIN + (size_t)3328 * 1024 * 2;
constexpr size_t W_WUQ = W_WGATE + (size_t)3072 * 1024 * 2;
constexpr size_t W_WK = W_WUQ + (size_t)768 * 256 * 2;
constexpr size_t W_WV = W_WK + (size_t)512 * 256 * 2;
constexpr size_t W_WGLU = W_WV + (size_t)512 * 256 * 2;
constexpr size_t W_WBR = W_WGLU + (size_t)512 * 512 * 2;
constexpr size_t W_WOUT = W_WBR + (size_t)3 * 1024 * 512 * 2;
constexpr size_t W_WGU = W_WOUT + (size_t)1024 * 1024 * 2;
constexpr size_t W_WD = W_WGU + (size_t)5632 * 1024 * 2;
constexpr size_t W_MB = W_WD + (size_t)1024 * 2816 * 2;
constexpr size_t W_MD = W_MB + (size_t)32 * 256 * 256 * 2;
constexpr size_t W_A16 = W_MD + (size_t)32 * 256 * 384 * 2;
constexpr size_t W_END = W_A16 + (size_t)32 * 64 * 2 * 4;
constexpr size_t O_HRES = al256(W_END);
constexpr size_t O_HBF = O_HRES + (size_t)T * 1024 * 4;
constexpr size_t O_COS = O_HBF + (size_t)T * 1024 * 2;
constexpr size_t O_SIN = O_COS + (size_t)T * 16 * 4;
constexpr size_t O_SSQ = O_SIN + (size_t)T * 16 * 4;
constexpr size_t O_HGDEC = al256(O_SSQ + (size_t)2 * T * 4);
constexpr size_t O_ZHG = al256(O_HGDEC + (size_t)64 * HGC * 128 * 4);
constexpr size_t O_CQKV = O_ZHG + (size_t)T * 2048 * 2;
constexpr size_t O_KA = O_CQKV + (size_t)T * 512 * 2;
constexpr size_t O_VT = O_KA + (size_t)T * 512 * 2 + 65536;
constexpr size_t O_EBUF = O_VT + (size_t)T * 512 * 2 + 65536;
constexpr size_t O_KR = O_EBUF + (size_t)32 * LSEQ * 128 * 4;
constexpr size_t O_BAR = O_KR + (size_t)T * 32 * 2 + 65536;
constexpr size_t O_STATS = O_BAR + 16384;
constexpr size_t O_COLV = O_STATS + (size_t)4 * T * 2 * 4;
constexpr int CV_IN = 0, CV_GATE = 2 * 3328, CV_GU = CV_GATE + 2 * 3072, CV_TOTAL = CV_GU + 2 * 5632;
constexpr size_t O_WSEND = O_COLV + (size_t)CV_TOTAL * 4 + 256;
constexpr size_t O_O = O_CQKV, O_S5OUT = O_KA, O_HGOUT = O_VT, O_YGELU = O_EBUF, O_GATEB = O_ZHG, O_MIXED = O_ZHG + (size_t)T * 1024 * 2, O_HFF = O_ZHG;
constexpr size_t X_UG = 0;
constexpr size_t X_QA = (size_t)32 * SROWS * 384 * 2;
constexpr size_t X_SLOC = X_QA;
static_assert(X_SLOC + (size_t)64 * HGC * 128 * 128 * 2 <= (size_t)NB * 2048 * 1024 * 4, "sloc fits d_out");
static_assert(X_QA + (size_t)(T + 16) * 768 * 2 <= (size_t)NB * 2048 * 1024 * 4, "qa fits d_out");
static_assert(O_WSEND <= (size_t)4 * NB * 2048 * 1024 * 4, "ws fits");
static_assert((size_t)T * 2816 * 2 <= (size_t)T * (2048 + 512 + 512) * 2, "hff fits");
constexpr int VTP = T;

constexpr int LDS_BYTES = 138240 + 16, LDS_BARST = 138240;
constexpr int HG_HALF = 69120, HG_CUM = 0, HG_KRAW = 33280, HG_VT = 50688, CUMP = 130, KRP = 136, VTPP = 72;

struct Params { const void* in[32]; float* out; unsigned char* ws; };
typedef const __attribute__((address_space(4))) Params* KP;
__device__ __forceinline__ KP kp_launder(KP q) { asm volatile("" : "+s"(q)); return q; }
__device__ __forceinline__ KP kparams() { return kp_launder((KP)__builtin_amdgcn_kernarg_segment_ptr()); }

DI int otid() { int t = threadIdx.x; asm volatile("" : "+v"(t)); return t; }
DI int obid() { int b = blockIdx.x; asm volatile("" : "+s"(b)); return b; }
DI int ogrid() { int g = gridDim.x; asm volatile("" : "+s"(g)); return g; }
DI unsigned pk2(float lo, float hi) { f32x2 v = {lo, hi}; bfv2 b = __builtin_convertvector(v, bfv2); return __builtin_bit_cast(unsigned, b); }
DI bf16_t f2bf(float x) { return (bf16_t)(pk2(x, 0.f) & 0xffffu); }
DI float bf2f(bf16_t b) { return __uint_as_float((unsigned)b << 16); }
DI float bflo(unsigned w) { return __uint_as_float(w << 16); }
DI float bfhi(unsigned w) { return __uint_as_float(w & 0xffff0000u); }
DI float sigm(float x) { return 1.f / (1.f + __expf(-x)); }
DI float gelu_tanh(float x) { const float u = 0.7978845608028654f * (x + 0.044715f * x * x * x); const float t = 1.f - 2.f / (1.f + __expf(2.f * u)); return 0.5f * x * (1.f + t); }
DI u32x4 pack8(const f32x4 a, const f32x4 b) { u32x4 w; w.x = pk2(a[0], a[1]); w.y = pk2(a[2], a[3]); w.z = pk2(b[0], b[1]); w.w = pk2(b[2], b[3]); return w; }

DI void ln_stats(const float* st, int r, float& mu, float& rs) { const f32x2 v = *(const f32x2*)(st + (size_t)r * 2); mu = v.x * (1.f / 1024.f); rs = rsqrtf(fmaxf(v.y * (1.f / 1024.f) - mu * mu, 0.f) + 1e-5f); }
DI void ln_fix(f32x4& v0, f32x4& v1, float mu, float rs, const float* cs, const float* bw, int col) {
    const f32x4 c0 = *(const f32x4*)(cs + col), c1 = *(const f32x4*)(cs + col + 4), b0 = *(const f32x4*)(bw + col), b1 = *(const f32x4*)(bw + col + 4);
    v0 = (v0 - c0 * mu) * rs + b0; v1 = (v1 - c1 * mu) * rs + b1; }

struct CV4 { f32x4 c0, c1, b0, b1; };
DI CV4 cv_load(const float* cs, const float* bw, int col) { CV4 v; v.c0 = *(const f32x4*)(cs + col); v.c1 = *(const f32x4*)(cs + col + 4); v.b0 = *(const f32x4*)(bw + col); v.b1 = *(const f32x4*)(bw + col + 4); return v; }
DI void ln_fix2(f32x4& v0, f32x4& v1, float mu, float rs, const CV4& c) { v0 = (v0 - c.c0 * mu) * rs + c.b0; v1 = (v1 - c.c1 * mu) * rs + c.b1; }

namespace pg8 {
constexpr int BM = 256, BK = 64, HALF = 128, HTB = HALF * BK * 2, STAGE_BYTES = 8 * HTB;
DI int lds_byte(int r, int c) { const int st = (r >> 4) * 2 + (c >> 5), rr = r & 15, cc = c & 31, ob = rr * 64 + cc * 2; return st * 1024 + (ob ^ (((ob >> 9) & 1) << 5)); }
DI void stage_rc(int b, int& R, int& C) { const int st = b / 1024, sb = b % 1024, swz = sb ^ (((sb >> 9) & 1) << 5); R = (st >> 1) * 16 + swz / 64; C = (st & 1) * 32 + (swz % 64) / 2; }
DI int perm32(int rho) { const int n = rho >> 4, i = rho & 15; return 8 * (i >> 2) + 4 * n + (i & 3); }

struct GUnit { const char* a; const char* b; int pm, pn, tag; };

template <class Epi, class Sched>
DI void gemm_phase(LAS unsigned char* lds, const Sched& S, const Epi& E) {
    const int tid = otid(), wid = __builtin_amdgcn_readfirstlane(tid >> 6), lane = tid & 63, wr = wid >> 2, wc = wid & 3, fr = lane & 15, fq = lane >> 4;
    int sR[2], sC[2], sRb[2];
#pragma unroll
    for (int i = 0; i < 2; ++i) { int R, C; stage_rc(tid * 16 + i * 8192, R, C); sR[i] = R; sC[i] = C; sRb[i] = (R & ~31) + perm32(R & 31); }
    const size_t kstep = (size_t)(BK * 2);
    const unsigned ldsw = (unsigned)wid * 1024u;
    const int aoff = lds_byte(wr * 64 + fr, fq * 8), boff = lds_byte(wc * 32 + fr, fq * 8);
#define PG8_SA(b, h) (((b) * 2 + (h)) * HTB)
#define PG8_SB(b, h) ((4 + (b) * 2 + (h)) * HTB)
#define PG8_STAGE(bufoff, gbase, v0, v1) do { \
        __builtin_amdgcn_global_load_lds((const unsigned*)((const char*)(gbase) + (v0)), (LAS unsigned*)(lds + (bufoff) + ldsw), 16, 0, 0); \
        __builtin_amdgcn_global_load_lds((const unsigned*)((const char*)(gbase) + (v1)), (LAS unsigned*)(lds + (bufoff) + ldsw + 8192), 16, 0, 0); } while (0)
#define PG8_LDA(dst, b, h) do { _Pragma("unroll") for (int m = 0; m < 4; ++m) _Pragma("unroll") for (int k = 0; k < 2; ++k) dst[m][k] = *(const LAS bf16x8*)(lds + PG8_SA(b, h) + aoff + m * 2048 + k * 1024); } while (0)
#define PG8_LDB(dst, b, h) do { _Pragma("unroll") for (int n = 0; n < 2; ++n) _Pragma("unroll") for (int k = 0; k < 2; ++k) dst[n][k] = *(const LAS bf16x8*)(lds + PG8_SB(b, h) + boff + n * 2048 + k * 1024); } while (0)
#define PG8_MMA(ai, bj, At, Bt) do { __builtin_amdgcn_s_setprio(1); _Pragma("unroll") for (int m = 0; m < 4; ++m) _Pragma("unroll") for (int n = 0; n < 2; ++n) _Pragma("unroll") for (int k = 0; k < 2; ++k) \
        acc[ai][bj][m][n] = __builtin_amdgcn_mfma_f32_16x16x32_bf16(Bt[n][k], At[m][k], acc[ai][bj][m][n], 0, 0, 0); __builtin_amdgcn_s_setprio(0); } while (0)
#define PG8_WAIT_V(n) asm volatile("s_waitcnt vmcnt(" #n ")" ::: "memory")
#define PG8_WAIT_L(n) asm volatile("s_waitcnt lgkmcnt(" #n ")" ::: "memory")
#define PG8_BAR __builtin_amdgcn_s_barrier()
#define PG8_SCHED __builtin_amdgcn_sched_barrier(0)
    GUnit cur, nxt; int ui = 0;
    if (!S.next(0, cur)) return;
    f32x4 acc[2][2][4][2];
#pragma unroll
    for (int a = 0; a < 2; ++a)
#pragma unroll
        for (int b = 0; b < 2; ++b)
#pragma unroll
            for (int m = 0; m < 4; ++m)
#pragma unroll
                for (int n = 0; n < 2; ++n) acc[a][b][m][n] = (f32x4){0.f, 0.f, 0.f, 0.f};
    bf16x8 At[4][2], B0[2][2], B1[2][2];
    const char* cA = cur.a; const char* cB = cur.b;
    const int lda = S.lda, ldb = S.ldb, nt = S.nt;
    const unsigned vA0 = (unsigned)(sR[0] * lda + sC[0]) * 2u, vA1 = (unsigned)(sR[1] * lda + sC[1]) * 2u;
    const unsigned vB0 = (unsigned)(sRb[0] * ldb + sC[0]) * 2u, vB1 = (unsigned)(sRb[1] * ldb + sC[1]) * 2u;
    const size_t hA = (size_t)HALF * lda * 2, hB = (size_t)HALF * ldb * 2;
    PG8_STAGE(PG8_SB(0, 0), cB, vB0, vB1); PG8_STAGE(PG8_SB(0, 1), cB + hB, vB0, vB1); PG8_STAGE(PG8_SA(0, 0), cA, vA0, vA1); PG8_STAGE(PG8_SA(0, 1), cA + hA, vA0, vA1);
    if (wr == 1) PG8_BAR;
    PG8_WAIT_V(2); PG8_BAR;
    PG8_STAGE(PG8_SB(1, 0), cB + kstep, vB0, vB1); PG8_STAGE(PG8_SA(1, 0), cA + kstep, vA0, vA1); PG8_STAGE(PG8_SB(1, 1), cB + hB + kstep, vB0, vB1);
    PG8_WAIT_V(6); PG8_BAR;
    for (;;) {
        const bool has_next = S.next(ui + 1, nxt);
        const char* nA = has_next ? nxt.a : cA; const char* nB = has_next ? nxt.b : cB;
        for (int t = 0; t < nt; t += 2) {
            const bool last = (t == nt - 2);
            const char* a1 = cA + (size_t)(t + 1) * kstep;
            const char* a2 = last ? nA : cA + (size_t)(t + 2) * kstep; const char* b2 = last ? nB : cB + (size_t)(t + 2) * kstep;
            const char* a3 = a2 + kstep; const char* b3 = b2 + kstep;
            PG8_LDB(B0, 0, 0); PG8_LDB(B1, 0, 1); PG8_SCHED; PG8_LDA(At, 0, 0); PG8_STAGE(PG8_SA(1, 1), a1 + hA, vA0, vA1);
            PG8_WAIT_V(8); PG8_WAIT_L(0); PG8_BAR; PG8_MMA(0, 0, At, B0); PG8_MMA(0, 1, At, B1); PG8_BAR; PG8_SCHED;
            PG8_LDA(At, 0, 1); PG8_STAGE(PG8_SB(0, 0), b2, vB0, vB1); PG8_STAGE(PG8_SB(0, 1), b2 + hB, vB0, vB1); PG8_STAGE(PG8_SA(0, 0), a2, vA0, vA1);
            PG8_WAIT_V(8); PG8_WAIT_L(0); PG8_BAR; PG8_MMA(1, 0, At, B0); PG8_MMA(1, 1, At, B1); PG8_BAR; PG8_SCHED;
            PG8_LDB(B0, 1, 0); PG8_LDB(B1, 1, 1); PG8_SCHED; PG8_LDA(At, 1, 0); PG8_STAGE(PG8_SA(0, 1), a2 + hA, vA0, vA1);
            PG8_WAIT_V(8); PG8_WAIT_L(0); PG8_BAR; PG8_MMA(0, 0, At, B0); PG8_MMA(0, 1, At, B1); PG8_BAR; PG8_SCHED;
            PG8_LDA(At, 1, 1); PG8_STAGE(PG8_SB(1, 0), b3, vB0, vB1); PG8_STAGE(PG8_SB(1, 1), b3 + hB, vB0, vB1); PG8_STAGE(PG8_SA(1, 0), a3, vA0, vA1);
            PG8_WAIT_V(8); PG8_WAIT_L(0); PG8_BAR; PG8_MMA(1, 0, At, B0); PG8_MMA(1, 1, At, B1); PG8_BAR; PG8_SCHED;
        }
        if (wr == 0) PG8_BAR;
        E(acc, cur, wr, wc, fr, fq);
        if (!has_next) break;
#pragma unroll
        for (int a = 0; a < 2; ++a)
#pragma unroll
            for (int b = 0; b < 2; ++b)
#pragma unroll
                for (int m = 0; m < 4; ++m)
#pragma unroll
                    for (int n = 0; n < 2; ++n) acc[a][b][m][n] = (f32x4){0.f, 0.f, 0.f, 0.f};
        cur = nxt; cA = nA; cB = nB; ++ui;
        if (wr == 1) PG8_BAR;
    }
    PG8_WAIT_V(0);
    PG8_BAR;
#undef PG8_SA
#undef PG8_SB
#undef PG8_STAGE
#undef PG8_LDA
#undef PG8_LDB
#undef PG8_MMA
#undef PG8_WAIT_V
#undef PG8_WAIT_L
#undef PG8_BAR
#undef PG8_SCHED
}

struct SchedGrid {
    const char* A; const char* B; int lda, ldb, nt, nM, nN, G, c;
    DI bool next(int i, GUnit& u) const {
        const int nwg = nM * nN; const long L = (long)i * G + c; if (L >= nwg) return false;
        int wgid = (int)L; { const int q = nwg / 8, r = nwg % 8, xcd = wgid % 8, off = wgid / 8; wgid = (xcd < r ? xcd * (q + 1) : r * (q + 1) + (xcd - r) * q) + off; }
        const int nig = 8 * nN, gid = wgid / nig, fm = gid * 8, gsz = (nM - fm) < 8 ? (nM - fm) : 8;
        u.pm = fm + ((wgid % nig) % gsz); u.pn = (wgid % nig) / gsz;
        u.a = A + (size_t)u.pm * 256 * lda * 2; u.b = B + (size_t)u.pn * 256 * ldb * 2; u.tag = 0; return true;
    }
};
}
using pg8::GUnit;

#define EPI_ROWS(ai, m) (u.pm * 256 + (ai) * 128 + wr * 64 + (m) * 16 + fr)
#define EPI_COL(bj) (u.pn * 256 + (bj) * 128 + wc * 32 + 8 * fq)

struct EpiA {
    bf16_t* ug; bf16_t* zhg; bf16_t* cqkv; bf16_t* kr; float* ssq; const float* cosT; const float* sinT; const float* st; const float* cs; const float* bw;
    DI void operator()(const f32x4 (&acc_)[2][2][4][2], const GUnit& u, int wr, int wc, int fr, int fq) const {
        const int pn = u.pn;
        CV4 cv0, cv1; if (st) { cv0 = cv_load(cs, bw, EPI_COL(0)); cv1 = cv_load(cs, bw, EPI_COL(1)); }
#pragma unroll
        for (int ai = 0; ai < 2; ++ai)
#pragma unroll
            for (int m = 0; m < 4; ++m) {
                const int r = EPI_ROWS(ai, m);
                f32x4 acc[2][2][4][2];
                acc[ai][0][m][0] = acc_[ai][0][m][0]; acc[ai][0][m][1] = acc_[ai][0][m][1]; acc[ai][1][m][0] = acc_[ai][1][m][0]; acc[ai][1][m][1] = acc_[ai][1][m][1];
                if (st) { float mu, rs; ln_stats(st, r, mu, rs);
                    ln_fix2(acc[ai][0][m][0], acc[ai][0][m][1], mu, rs, cv0); ln_fix2(acc[ai][1][m][0], acc[ai][1][m][1], mu, rs, cv1); }
                if (pn < 2) {
                    const int b = r / LSEQ, tt = r - b * LSEQ, chunk = tt >> 4, s = tt & 15;
#pragma unroll
                    for (int bj = 0; bj < 2; ++bj) { const int col = EPI_COL(bj); const int g = col >> 4, c = col & 15;
                        *(u32x4*)(ug + ((size_t)(g * SROWS + b * NCHK + chunk) * 384 + s * 16 + c)) = pack8(acc[ai][bj][m][0], acc[ai][bj][m][1]); }
                } else if (pn < 10) {
#pragma unroll
                    for (int bj = 0; bj < 2; ++bj) { const int col = EPI_COL(bj) - 512;
                        *(u32x4*)(zhg + ((size_t)r * 2048 + col)) = pack8(acc[ai][bj][m][0], acc[ai][bj][m][1]); }
                } else if (pn < 12) {
                    float sq = 0.f;
#pragma unroll
                    for (int bj = 0; bj < 2; ++bj) { const int col = EPI_COL(bj) - 2560;
                        const f32x4 v0 = acc[ai][bj][m][0], v1 = acc[ai][bj][m][1];
                        sq += v0[0] * v0[0] + v0[1] * v0[1] + v0[2] * v0[2] + v0[3] * v0[3] + v1[0] * v1[0] + v1[1] * v1[1] + v1[2] * v1[2] + v1[3] * v1[3];
                        *(u32x4*)(cqkv + ((size_t)r * 512 + col)) = pack8(v0, v1); }
                    sq += __shfl_xor(sq, 16); sq += __shfl_xor(sq, 32);
                    if (fq == 0) atomicAdd(ssq + (size_t)(pn - 10) * T + r, sq);
                } else {
                    f32x4 v0 = acc[ai][0][m][0], v1 = acc[ai][0][m][1];
                    f32x4 o0, o1;
#pragma unroll
                    for (int e = 0; e < 4; ++e) { o0[e] = __shfl_xor(v0[e], 32); o1[e] = __shfl_xor(v1[e], 32); }
                    if (wc == 0) {
                        const int ib = 8 * (fq & 1);
                        const f32x4 c0 = *(const f32x4*)(cosT + (size_t)r * 16 + ib), c1 = *(const f32x4*)(cosT + (size_t)r * 16 + ib + 4);
                        const f32x4 s0 = *(const f32x4*)(sinT + (size_t)r * 16 + ib), s1 = *(const f32x4*)(sinT + (size_t)r * 16 + ib + 4);
                        f32x4 r0, r1;
                        if (fq < 2) { r0 = v0 * c0 - o0 * s0; r1 = v1 * c1 - o1 * s1; } else { r0 = o0 * s0 + v0 * c0; r1 = o1 * s1 + v1 * c1; }
                        *(u32x4*)(kr + ((size_t)r * 32 + 8 * fq)) = pack8(r0, r1);
                    }
                }
            }
    }
};

struct EpiB {
    bf16_t* qa; bf16_t* ka; bf16_t* vt; float* ebuf; const float* ssq; const float* cosT; const float* sinT;
    DI void operator()(const f32x4 (&acc)[2][2][4][2], const GUnit& u, int wr, int wc, int fr, int fq) const {
        if (u.tag == 0) {
#pragma unroll
            for (int ai = 0; ai < 2; ++ai)
#pragma unroll
                for (int m = 0; m < 4; ++m) {
                    const int r = EPI_ROWS(ai, m);
                    const float rs = rsqrtf(ssq[r] * (1.f / 256.f) + 1e-6f);
#pragma unroll
                    for (int bj = 0; bj < 2; ++bj) {
                        const int g32 = u.pn * 8 + bj * 4 + wc;
                        f32x4 v0 = acc[ai][bj][m][0] * rs, v1 = acc[ai][bj][m][1] * rs;
                        f32x4 o0, o1;
#pragma unroll
                        for (int e = 0; e < 4; ++e) { o0[e] = __shfl_xor(v0[e], 32); o1[e] = __shfl_xor(v1[e], 32); }
                        if (g32 % 3 == 2) {
                            const int ib = 8 * (fq & 1);
                            const f32x4 c0 = *(const f32x4*)(cosT + (size_t)r * 16 + ib), c1 = *(const f32x4*)(cosT + (size_t)r * 16 + ib + 4);
                            const f32x4 s0 = *(const f32x4*)(sinT + (size_t)r * 16 + ib), s1 = *(const f32x4*)(sinT + (size_t)r * 16 + ib + 4);
                            if (fq < 2) { v0 = v0 * c0 - o0 * s0; v1 = v1 * c1 - o1 * s1; } else { v0 = o0 * s0 + v0 * c0; v1 = o1 * s1 + v1 * c1; }
                        }
                        *(u32x4*)(qa + ((size_t)r * 768 + EPI_COL(bj))) = pack8(v0, v1);
                    }
                }
        } else if (u.tag == 1) {
#pragma unroll
            for (int ai = 0; ai < 2; ++ai)
#pragma unroll
                for (int m = 0; m < 4; ++m) {
                    const int r = EPI_ROWS(ai, m);
                    const float rs = rsqrtf(ssq[T + r] * (1.f / 256.f) + 1e-6f);
#pragma unroll
                    for (int bj = 0; bj < 2; ++bj) *(u32x4*)(ka + ((size_t)r * 512 + EPI_COL(bj))) = pack8(acc[ai][bj][m][0] * rs, acc[ai][bj][m][1] * rs);
                }
        } else if (u.tag == 2) {
#pragma unroll
            for (int bj = 0; bj < 2; ++bj) {
                const int col = EPI_COL(bj);
                f32x4 rs0, rs1;
#pragma unroll
                for (int e = 0; e < 4; ++e) { rs0[e] = rsqrtf(ssq[T + col + e] * (1.f / 256.f) + 1e-6f); rs1[e] = rsqrtf(ssq[T + col + 4 + e] * (1.f / 256.f) + 1e-6f); }
#pragma unroll
                for (int ai = 0; ai < 2; ++ai)
#pragma unroll
                    for (int m = 0; m < 4; ++m) { const int r = EPI_ROWS(ai, m);
                        *(u32x4*)(vt + ((size_t)r * VTP + col)) = pack8(acc[ai][bj][m][0] * rs0, acc[ai][bj][m][1] * rs1); }
            }
        } else {
            const int g = u.pm / 9, rt = u.pm - g * 9;
#pragma unroll
            for (int ai = 0; ai < 2; ++ai)
#pragma unroll
                for (int m = 0; m < 4; ++m) {
                    const int R = rt * 256 + ai * 128 + wr * 64 + m * 16 + fr;
                    if (R < LSEQ) { float* p = ebuf + ((size_t)(g * LSEQ + R) * 128 + wc * 32 + 8 * fq);
                        *(f32x4*)p = acc[ai][0][m][0]; *(f32x4*)(p + 4) = acc[ai][0][m][1]; }
                }
        }
    }
};
struct SchedB {
    const char* A; const char* B; int lda, ldb, nt, tag, G, c;
    DI bool next(int i, GUnit& u) const {
        const int L = i * G + c; u.tag = tag;
        if (tag == 0) { if (L >= 387) return false; u.pm = L / 3; u.pn = L % 3; u.a = A + (size_t)u.pm * 256 * 512 * 2; u.b = B + (size_t)u.pn * 256 * 256 * 2; return true; }
        if (L >= 258) return false;
        if (tag == 1) { u.pm = L / 2; u.pn = L % 2; u.a = A + (size_t)u.pm * 256 * 512 * 2; u.b = B + (size_t)u.pn * 256 * 256 * 2; return true; }
        u.pm = L % 2; u.pn = L / 2; u.a = A + (size_t)u.pm * 256 * 256 * 2; u.b = B + (size_t)u.pn * 256 * 512 * 2; return true;
    }
};

struct EpiS5Y {
    bf16_t* yg;
    DI void operator()(const f32x4 (&acc)[2][2][4][2], const GUnit& u, int wr, int wc, int fr, int fq) const {
        const int g = u.pm / 9, rt = u.pm - g * 9;
#pragma unroll
        for (int ai = 0; ai < 2; ++ai)
#pragma unroll
            for (int m = 0; m < 4; ++m) {
                const int R = rt * 256 + ai * 128 + wr * 64 + m * 16 + fr;
                if (R < LSEQ) {
                    const int b = R / NCHK, chunk = R - b * NCHK;
#pragma unroll
                    for (int bj = 0; bj < 2; ++bj) {
                        const int col = bj * 128 + wc * 32 + 8 * fq, t = col >> 4, co = col & 15;
                        f32x4 v0 = acc[ai][bj][m][0], v1 = acc[ai][bj][m][1];
#pragma unroll
                        for (int e = 0; e < 4; ++e) { v0[e] = gelu_tanh(v0[e]); v1[e] = gelu_tanh(v1[e]); }
                        *(u32x4*)(yg + ((size_t)(b * LSEQ + chunk * 16 + t) * 512 + g * 16 + co)) = pack8(v0, v1);
                    }
                }
            }
    }
};
struct SchedS5 {
    const char* ug; const char* mat; int lda, ldb, nt, tag, G, c;
    DI bool next(int i, GUnit& u) const {
        const int L = i * G + c; if (L >= 288) return false;
        const int g = L / 9, rt = L - g * 9; u.tag = tag; u.pm = L; u.pn = 0;
        u.a = ug + ((size_t)g * SROWS + rt * 256) * 384 * 2; u.b = mat + (size_t)g * 256 * ldb * 2; return true;
    }
};

struct EpiGlu {
    const bf16_t* yg; bf16_t* out;
    DI void operator()(const f32x4 (&acc)[2][2][4][2], const GUnit& u, int wr, int wc, int fr, int fq) const {
#pragma unroll
        for (int ai = 0; ai < 2; ++ai)
#pragma unroll
            for (int m = 0; m < 4; ++m) { const int r = EPI_ROWS(ai, m);
#pragma unroll
                for (int bj = 0; bj < 2; ++bj) { const size_t off = (size_t)r * 512 + EPI_COL(bj);
                    const u32x4 y = *(const u32x4*)(yg + off); const f32x4 a0 = acc[ai][bj][m][0], a1 = acc[ai][bj][m][1];
                    f32x4 v0, v1;
                    v0[0] = bflo(y.x) * sigm(a0[0]); v0[1] = bfhi(y.x) * sigm(a0[1]); v0[2] = bflo(y.y) * sigm(a0[2]); v0[3] = bfhi(y.y) * sigm(a0[3]);
                    v1[0] = bflo(y.z) * sigm(a1[0]); v1[1] = bfhi(y.z) * sigm(a1[1]); v1[2] = bflo(y.w) * sigm(a1[2]); v1[3] = bfhi(y.w) * sigm(a1[3]);
                    *(u32x4*)(out + off) = pack8(v0, v1); } }
    }
};

struct EpiF {
    bf16_t* gateb; bf16_t* mixed; const float* st; const float* cs; const float* bw;
    DI void operator()(const f32x4 (&acc)[2][2][4][2], const GUnit& u, int wr, int wc, int fr, int fq) const {
        const int j = u.tag;
        CV4 cvv[2]; if (st && (j & 1) == 0) { cvv[0] = cv_load(cs, bw, (j >> 1) * 1024 + EPI_COL(0)); cvv[1] = cv_load(cs, bw, (j >> 1) * 1024 + EPI_COL(1)); }
#pragma unroll
        for (int ai = 0; ai < 2; ++ai)
#pragma unroll
            for (int m = 0; m < 4; ++m) { const int r = EPI_ROWS(ai, m);
                float mu = 0.f, rs = 1.f; if (st && (j & 1) == 0) ln_stats(st, r, mu, rs);
#pragma unroll
                for (int bj = 0; bj < 2; ++bj) { const size_t off = (size_t)r * 1024 + EPI_COL(bj);
                    f32x4 a0 = acc[ai][bj][m][0], a1 = acc[ai][bj][m][1];
                    if ((j & 1) == 0) {
                        if (st) ln_fix2(a0, a1, mu, rs, cvv[bj]);
#pragma unroll
                        for (int e = 0; e < 4; ++e) { a0[e] = sigm(a0[e]); a1[e] = sigm(a1[e]); }
                        *(u32x4*)(gateb + off) = pack8(a0, a1);
                    } else {
                        const u32x4 gt = *(const u32x4*)(gateb + off);
                        a0[0] *= bflo(gt.x); a0[1] *= bfhi(gt.x); a0[2] *= bflo(gt.y); a0[3] *= bfhi(gt.y);
                        a1[0] *= bflo(gt.z); a1[1] *= bfhi(gt.z); a1[2] *= bflo(gt.w); a1[3] *= bfhi(gt.w);
                        if (j > 1) { const u32x4 mx = *(const u32x4*)(mixed + off);
                            a0[0] += bflo(mx.x); a0[1] += bfhi(mx.x); a0[2] += bflo(mx.y); a0[3] += bfhi(mx.y);
                            a1[0] += bflo(mx.z); a1[1] += bfhi(mx.z); a1[2] += bflo(mx.w); a1[3] += bfhi(mx.w); }
                        *(u32x4*)(mixed + off) = pack8(a0, a1);
                    } } }
    }
};
struct SchedF {
    const char* A; const char* B; int lda, ldb, nt, j, G, c;
    DI bool next(int i, GUnit& u) const {
        const int tI = i * G + c; if (tI >= 516) return false;
        u.pm = tI >> 2; u.pn = tI & 3; u.tag = j;
        u.a = A + (size_t)u.pm * 256 * lda * 2; u.b = B + (size_t)u.pn * 256 * ldb * 2; return true;
    }
};

struct EpiRes {
    float* hres; bf16_t* hbf; const float* st_in; const float* g_in; const float* b_in; float* st_out;
    DI void operator()(const f32x4 (&acc)[2][2][4][2], const GUnit& u, int wr, int wc, int fr, int fq) const {
        CV4 gb[2]; if (st_in) { gb[0] = cv_load(g_in, b_in, EPI_COL(0)); gb[1] = cv_load(g_in, b_in, EPI_COL(1)); }
#pragma unroll
        for (int ai = 0; ai < 2; ++ai)
#pragma unroll
            for (int m = 0; m < 4; ++m) { const int r = EPI_ROWS(ai, m);
                float mu = 0.f, rs = 1.f; if (st_in) ln_stats(st_in, r, mu, rs);
                float a1 = 0.f, a2 = 0.f;
#pragma unroll
                for (int bj = 0; bj < 2; ++bj) { const int col = EPI_COL(bj); float* p = hres + (size_t)r * 1024 + col;
                    f32x4 h0 = *(const f32x4*)p, h1 = *(const f32x4*)(p + 4);
                    if (st_in) { h0 = (h0 - mu) * rs * gb[bj].c0 + gb[bj].b0; h1 = (h1 - mu) * rs * gb[bj].c1 + gb[bj].b1; }
                    const f32x4 r0 = h0 * ALPHA + acc[ai][bj][m][0], r1 = h1 * ALPHA + acc[ai][bj][m][1];
                    *(f32x4*)p = r0; *(f32x4*)(p + 4) = r1;
                    *(u32x4*)(hbf + (size_t)r * 1024 + col) = pack8(r0, r1);
                    a1 += (r0[0] + r0[1]) + (r0[2] + r0[3]) + (r1[0] + r1[1]) + (r1[2] + r1[3]);
                    a2 += (r0[0] * r0[0] + r0[1] * r0[1]) + (r0[2] * r0[2] + r0[3] * r0[3]) + (r1[0] * r1[0] + r1[1] * r1[1]) + (r1[2] * r1[2] + r1[3] * r1[3]); }
                a1 += __shfl_xor(a1, 16); a1 += __shfl_xor(a1, 32); a2 += __shfl_xor(a2, 16); a2 += __shfl_xor(a2, 32);
                if (fq == 0) { atomicAdd(st_out + (size_t)r * 2, a1); atomicAdd(st_out + (size_t)r * 2 + 1, a2); } }
    }
};
struct EpiFfn1 {
    bf16_t* hff; const float* st; const float* cs; const float* bw;
    DI void operator()(const f32x4 (&acc)[2][2][4][2], const GUnit& u, int wr, int wc, int fr, int fq) const {
        const CV4 cvg = cv_load(cs, bw, EPI_COL(0)), cvu = cv_load(cs, bw, EPI_COL(1));
#pragma unroll
        for (int ai = 0; ai < 2; ++ai)
#pragma unroll
            for (int m = 0; m < 4; ++m) { const int r = EPI_ROWS(ai, m);
                f32x4 v0, v1; f32x4 g0 = acc[ai][0][m][0], g1 = acc[ai][0][m][1], u0 = acc[ai][1][m][0], u1 = acc[ai][1][m][1];
                { float mu, rs; ln_stats(st, r, mu, rs); ln_fix2(g0, g1, mu, rs, cvg); ln_fix2(u0, u1, mu, rs, cvu); }
#pragma unroll
                for (int e = 0; e < 4; ++e) { v0[e] = g0[e] * sigm(g0[e]) * u0[e]; v1[e] = g1[e] * sigm(g1[e]) * u1[e]; }
                *(u32x4*)(hff + ((size_t)r * DFF + u.pn * 128 + wc * 32 + 8 * fq)) = pack8(v0, v1); }
    }
};

template <class F> DI void tconv(bf16_t* dst, int N, int K, int gtid_, int gthreads, F f) {
    const int gtid = blockIdx.x * 512 + otid(); gthreads = ogrid() * 512;
    const int kb8 = K / 8; const long total = (long)N * kb8;
    for (long idx = gtid; idx < total; idx += gthreads) {
        const int n = (int)(idx % N), kb = (int)(idx / N);
        float v[8];
#pragma unroll
        for (int i = 0; i < 8; ++i) v[i] = f(n, kb * 8 + i);
        u32x4 w; w.x = pk2(v[0], v[1]); w.y = pk2(v[2], v[3]); w.z = pk2(v[4], v[5]); w.w = pk2(v[6], v[7]);
        *(u32x4*)(dst + ((size_t)n * K + kb * 8)) = w;
    }
}

template <class F> DI void colvec(float* cs, float* bw, int N, int K, const float* g, const float* b, LAS unsigned char* lds, F f) {
    LAS float* red = (LAS float*)lds;
    const int tid = otid(), nn = tid & 31, ks = tid >> 5, G = ogrid(), kper = K >> 4;
    for (int task = blockIdx.x; task * 32 < N; task += G) {
        const int n = task * 32 + nn; float a = 0.f, c = 0.f;
#pragma unroll 8
        for (int kk = 0; kk < kper; ++kk) { const int k = ks * kper + kk; const float w = f(n, k); a += bflo(pk2(w * g[k], 0.f)); c += b[k] * w; }
        __syncthreads();
        red[(ks * 32 + nn) * 2] = a; red[(ks * 32 + nn) * 2 + 1] = c;
        __syncthreads();
        if (tid < 32) { float sa = 0.f, sc = 0.f;
#pragma unroll
            for (int j = 0; j < 16; ++j) { sa += red[(j * 32 + tid) * 2]; sc += red[(j * 32 + tid) * 2 + 1]; }
            cs[task * 32 + tid] = sa; bw[task * 32 + tid] = sc; }
    }
    __syncthreads();
}
DI void convert_weights(KP p, int l, int part, LAS unsigned char* lds) {
    const int gtid = 0, gthreads = 0;
    p = kp_launder(p);
    unsigned char* ws = p->ws; float* cv = (float*)(ws + O_COLV);
    if (part == 0) {
    { const float* w = (const float*)p->in[5] + (size_t)l * 1024 * 6176; const float* g2 = (const float*)p->in[30] + (l - 1) * 1024; const float* b2 = (const float*)p->in[31] + (l - 1) * 1024; const bool fold = l > 0;
      auto fin = [=](int n, int k) -> float { const int src = n < 512 ? 544 + n : (n < 2560 ? 1056 + (n - 512) : (n < 3104 ? n - 2560 : -1)); return src < 0 ? 0.f : w[(size_t)k * 6176 + src]; };
      auto fgate = [=](int n, int k) -> float { return w[(size_t)k * 6176 + 3104 + n]; };
      tconv((bf16_t*)(ws + W_WIN), 3328, 1024, gtid, gthreads, [=](int n, int k) -> float { const float v = fin(n, k); return fold ? v * g2[k] : v; });
      tconv((bf16_t*)(ws + W_WGATE), 3072, 1024, gtid, gthreads, [=](int n, int k) -> float { const float v = fgate(n, k); return fold ? v * g2[k] : v; });
      if (fold) { colvec(cv + CV_IN, cv + CV_IN + 3328, 3328, 1024, g2, b2, lds, fin); colvec(cv + CV_GATE, cv + CV_GATE + 3072, 3072, 1024, g2, b2, lds, fgate); } }
    { const float* w = (const float*)p->in[7] + (size_t)l * 256 * 768; const float* g = (const float*)p->in[6] + l * 256;
      tconv((bf16_t*)(ws + W_WUQ), 768, 256, gtid, gthreads, [=](int n, int k) -> float { return w[(size_t)k * 768 + n] * g[k] * QSCALE; }); }
    { const float* w = (const float*)p->in[9] + (size_t)l * 256 * 1024; const float* g = (const float*)p->in[8] + l * 256;
      tconv((bf16_t*)(ws + W_WK), 512, 256, gtid, gthreads, [=](int n, int k) -> float { return w[(size_t)k * 1024 + (n >> 6) * 128 + (n & 63)] * g[k]; });
      tconv((bf16_t*)(ws + W_WV), 512, 256, gtid, gthreads, [=](int n, int k) -> float { return w[(size_t)k * 1024 + (n >> 6) * 128 + 64 + (n & 63)] * g[k]; }); }
    { const float* w = (const float*)p->in[18] + (size_t)l * 512 * 512;
      tconv((bf16_t*)(ws + W_WGLU), 512, 512, gtid, gthreads, [=](int n, int k) -> float { return w[(size_t)k * 512 + n]; }); }
#pragma unroll
    for (int br = 0; br < 3; ++br) { const float* w = (const float*)p->in[21 + br] + (size_t)l * 512 * 1024;
      tconv((bf16_t*)(ws + W_WBR) + (size_t)br * 1024 * 512, 1024, 512, gtid, gthreads, [=](int n, int k) -> float { return w[(size_t)k * 1024 + n]; }); }
    { const float* w = (const float*)p->in[24] + (size_t)l * 1024 * 1024;
      tconv((bf16_t*)(ws + W_WOUT), 1024, 1024, gtid, gthreads, [=](int n, int k) -> float { return w[(size_t)k * 1024 + n]; }); }
    } else {
    { const float* wg = (const float*)p->in[27] + (size_t)l * 1024 * DFF; const float* wu = (const float*)p->in[28] + (size_t)l * 1024 * DFF; const float* g1 = (const float*)p->in[25] + l * 1024; const float* b1 = (const float*)p->in[26] + l * 1024;
      auto fgu = [=](int n, int k) -> float { const int pn = n >> 8, r = n & 255; return r < 128 ? wg[(size_t)k * DFF + pn * 128 + r] : wu[(size_t)k * DFF + pn * 128 + r - 128]; };
      tconv((bf16_t*)(ws + W_WGU), 5632, 1024, gtid, gthreads, [=](int n, int k) -> float { return fgu(n, k) * g1[k]; });
      colvec(cv + CV_GU, cv + CV_GU + 5632, 5632, 1024, g1, b1, lds, fgu); }
    { const float* w = (const float*)p->in[29] + (size_t)l * DFF * 1024;
      tconv((bf16_t*)(ws + W_WD), 1024, DFF, gtid, gthreads, [=](int n, int k) -> float { return w[(size_t)k * 1024 + n]; }); }
    }
}

DI void s5_build(KP p, int l, int g, LAS unsigned char* lds) {
    p = kp_launder(p);
    LAS float* PT = (LAS float*)lds;
    LAS float* BB = PT + 64 * 17 * 2;
    LAS float* KT = BB + 64 * 16 * 2;
    const int tid = otid();
    const float* lam_re = (const float*)p->in[10] + (size_t)(l * 32 + g) * 64;
    const float* lam_im = (const float*)p->in[11] + (size_t)(l * 32 + g) * 64;
    const float dt = expf(((const float*)p->in[12])[l * 32 + g]);
    const float* b_re = (const float*)p->in[13] + (size_t)(l * 32 + g) * 64 * 16;
    const float* b_im = (const float*)p->in[14] + (size_t)(l * 32 + g) * 64 * 16;
    const float* c_re = (const float*)p->in[15] + (size_t)(l * 32 + g) * 16 * 64;
    const float* c_im = (const float*)p->in[16] + (size_t)(l * 32 + g) * 16 * 64;
    const float* dsk = (const float*)p->in[17] + (size_t)l * 512 + g * 16;
    __syncthreads();
    for (int idx = tid; idx < 64 * 17; idx += 512) {
        const int n = idx / 17, tau = idx - n * 17;
        const float lr = fminf(lam_re[n], -1e-4f), li = lam_im[n];
        const float mag = expf(lr * dt * (float)tau); float s, c; sincosf(li * dt * (float)tau, &s, &c);
        PT[idx * 2] = mag * c; PT[idx * 2 + 1] = mag * s;
    }
    for (int idx = tid; idx < 64 * 16; idx += 512) {
        const int n = idx >> 4;
        const float lr = fminf(lam_re[n], -1e-4f), li = lam_im[n];
        const float mag = expf(lr * dt); float s, c; sincosf(li * dt, &s, &c);
        const float abr = mag * c, abi = mag * s, den = lr * lr + li * li, nr = abr - 1.f;
        const float cr = (nr * lr + abi * li) / den, ci = (abi * lr - nr * li) / den;
        const float br = b_re[idx], bi = b_im[idx];
        BB[idx * 2] = cr * br - ci * bi; BB[idx * 2 + 1] = cr * bi + ci * br;
    }
    __syncthreads();
    for (int idx = tid; idx < 4096; idx += 512) {
        const int tau = idx >> 8, co = (idx >> 4) & 15, ci = idx & 15;
        float acc = 0.f;
        for (int n = 0; n < 64; ++n) {
            const float pr = PT[(n * 17 + tau) * 2], pi = PT[(n * 17 + tau) * 2 + 1], br = BB[(n * 16 + ci) * 2], bi = BB[(n * 16 + ci) * 2 + 1];
            const float xr = pr * br - pi * bi, xi = pr * bi + pi * br;
            acc += c_re[co * 64 + n] * xr - c_im[co * 64 + n] * xi;
        }
        KT[idx] = acc;
    }
    __syncthreads();
    bf16_t* mb = (bf16_t*)(p->ws + W_MB) + (size_t)g * 256 * 256;
    bf16_t* md = (bf16_t*)(p->ws + W_MD) + (size_t)g * 256 * 384;
    for (int idx = tid; idx < 256 * 256; idx += 512) {
        const int col = idx >> 8, k = idx & 255, s = k >> 4, c = k & 15; float v = 0.f;
        if (col < 128) { const int n = col & 63; const float pr = PT[(n * 17 + 15 - s) * 2], pi = PT[(n * 17 + 15 - s) * 2 + 1], br = BB[(n * 16 + c) * 2], bi = BB[(n * 16 + c) * 2 + 1];
            v = col < 64 ? pr * br - pi * bi : pr * bi + pi * br; }
        mb[idx] = f2bf(v);
    }
    for (int idx = tid; idx < 256 * 384; idx += 512) {
        const int row = idx / 384, k = idx - row * 384, t = row >> 4, co = row & 15; float v;
        if (k < 256) { const int s = k >> 4, ci = k & 15; v = s <= t ? KT[((t - s) * 16 + co) * 16 + ci] : 0.f; if (s == t && ci == co) v += dsk[co]; }
        else { const int n = (k - 256) & 63; const float pr = PT[(n * 17 + t + 1) * 2], pi = PT[(n * 17 + t + 1) * 2 + 1], cr = c_re[co * 64 + n], ci = c_im[co * 64 + n];
            v = k < 320 ? cr * pr - ci * pi : -(cr * pi + ci * pr); }
        md[idx] = f2bf(v);
    }
    if (tid < 64) { float* a16 = (float*)(p->ws + W_A16) + (size_t)g * 128; a16[tid * 2] = PT[(tid * 17 + 16) * 2]; a16[tid * 2 + 1] = PT[(tid * 17 + 16) * 2 + 1]; }
    __syncthreads();
}

DI void ln_rows(KP p, int mode, const float* gam, const float* bet, int gwave_, int nwaves, int lane_) {
    p = kp_launder(p);
    const int tid_ = otid(), lane = tid_ & 63, gwave = blockIdx.x * 8 + __builtin_amdgcn_readfirstlane(tid_ >> 6); nwaves = ogrid() * 8;
    float* hres = (float*)(p->ws + O_HRES); bf16_t* hbf = (bf16_t*)(p->ws + O_HBF);
    for (int r = gwave; r < T; r += nwaves) {
        const int b = r / LSEQ, tt = r - b * LSEQ;
        const float* src;
        if (mode == 0) src = tt < 16 ? (const float*)p->in[2] + (size_t)tt * 1024 : (const float*)p->in[0] + ((size_t)b * 2048 + tt - 16) * 1024;
        else src = hres + (size_t)r * 1024;
        if (mode == 2 && tt < 16) continue;
        f32x4 v[4]; float s = 0.f;
#pragma unroll
        for (int i = 0; i < 4; ++i) { v[i] = *(const f32x4*)(src + i * 256 + lane * 4); s += v[i][0] + v[i][1] + v[i][2] + v[i][3]; }
#pragma unroll
        for (int o = 1; o < 64; o <<= 1) s += __shfl_xor(s, o);
        const float mu = s * (1.f / 1024.f); float q = 0.f;
#pragma unroll
        for (int i = 0; i < 4; ++i) { const f32x4 d = v[i] - mu; q += d[0] * d[0] + d[1] * d[1] + d[2] * d[2] + d[3] * d[3]; }
#pragma unroll
        for (int o = 1; o < 64; o <<= 1) q += __shfl_xor(q, o);
        const float rstd = rsqrtf(q * (1.f / 1024.f) + 1e-5f);
#pragma unroll
        for (int i = 0; i < 4; ++i) {
            const int c = i * 256 + lane * 4;
            const f32x4 o = (v[i] - mu) * rstd * *(const f32x4*)(gam + c) + *(const f32x4*)(bet + c);
            if (mode == 2) *(f32x4*)(p->out + ((size_t)b * 2048 + tt - 16) * 1024 + c) = o;
            else { *(f32x4*)(hres + (size_t)r * 1024 + c) = o; u32x2 w; w.x = pk2(o[0], o[1]); w.y = pk2(o[2], o[3]); *(u32x2*)(hbf + (size_t)r * 1024 + c) = w; }
        }
    }
}

constexpr int AT_KP = 104, AT_VP = 36, AT_BUF = 32 * AT_KP * 2 + 64 * AT_VP * 2;
DI void attn_softmax_pv(f32x16& S, f32x16& O0, f32x16& O1, float& mrun, float& lsum, const bf16x8 (&vf)[2][2]) {
    float mx = S[0];
#pragma unroll
    for (int r = 1; r < 16; ++r) mx = fmaxf(mx, S[r]);
    mx = fmaxf(mx, __shfl_xor(mx, 32));
    const float mnew = fmaxf(mrun, mx);
    float ps = 0.f;
#pragma unroll
    for (int r = 0; r < 16; ++r) { S[r] = __builtin_amdgcn_exp2f(S[r] - mnew); ps += S[r]; }
    if (__builtin_amdgcn_ballot_w64(mnew > mrun) != 0ull) {
        const float alpha = __builtin_amdgcn_exp2f(mrun - mnew);
        lsum *= alpha;
#pragma unroll
        for (int i = 0; i < 16; ++i) { O0[i] *= alpha; O1[i] *= alpha; }
    }
    mrun = mnew; lsum += ps;
#pragma unroll
    for (int kk = 0; kk < 2; ++kk) {
        u32x4 w; w.x = pk2(S[8 * kk], S[8 * kk + 1]); w.y = pk2(S[8 * kk + 2], S[8 * kk + 3]); w.z = pk2(S[8 * kk + 4], S[8 * kk + 5]); w.w = pk2(S[8 * kk + 6], S[8 * kk + 7]);
        const bf16x8 pf = __builtin_bit_cast(bf16x8, w);
        O0 = __builtin_amdgcn_mfma_f32_32x32x16_bf16(vf[0][kk], pf, O0, 0, 0, 0);
        O1 = __builtin_amdgcn_mfma_f32_32x32x16_bf16(vf[1][kk], pf, O1, 0, 0, 0);
    }
}
DI void attn_store(bf16_t* oo, size_t tokq, int h, int half, const f32x16& O0, const f32x16& O1, float inv) {
#pragma unroll
    for (int blk = 0; blk < 4; ++blk) {
        u32x2 w0, w1;
        w0.x = pk2(O0[4 * blk] * inv, O0[4 * blk + 1] * inv); w0.y = pk2(O0[4 * blk + 2] * inv, O0[4 * blk + 3] * inv);
        w1.x = pk2(O1[4 * blk] * inv, O1[4 * blk + 1] * inv); w1.y = pk2(O1[4 * blk + 2] * inv, O1[4 * blk + 3] * inv);
        *(u32x2*)(oo + tokq * 512 + h * 64 + 8 * blk + 4 * half) = w0;
        *(u32x2*)(oo + tokq * 512 + h * 64 + 32 + 8 * blk + 4 * half) = w1;
    }
}
DI void attention_phase(KP p, LAS unsigned char* lds) {
    p = kp_launder(p);
    const int tid = otid(), lane = tid & 63, wid = __builtin_amdgcn_readfirstlane(tid >> 6);
    const bf16_t* qa = (const bf16_t*)((unsigned char*)p->out + X_QA);
    const bf16_t* ka = (const bf16_t*)(p->ws + O_KA); const bf16_t* kr = (const bf16_t*)(p->ws + O_KR); const bf16_t* vt = (const bf16_t*)(p->ws + O_VT);
    bf16_t* oo = (bf16_t*)(p->ws + O_O);
    const int G = ogrid(), l31 = lane & 31, half = lane >> 5;
    const bool c0k = tid < 384; const int c0 = c0k ? tid : tid - 384, c1 = tid + 128;
    for (int it = 0; it * G < 1024; ++it) {
        const int u = it * G + blockIdx.x;
        if (u >= 1024) break;
        const int bh = u & 127, pp = u >> 7, b = bh >> 3, h = bh & 7;
        const int j = (0x46315720 >> (4 * pp)) & 7;
        const int ktmax = 8 * j + 8, dkt = 8 * j + wid + 1;
        const size_t tok0 = (size_t)b * LSEQ;
        const size_t tokq = tok0 + 16 + 256 * j + 32 * wid + l31;
        bf16x8 qf[6];
#pragma unroll
        for (int ks = 0; ks < 6; ++ks) qf[ks] = *(const bf16x8*)(qa + tokq * 768 + h * 96 + ks * 16 + half * 8);
        f32x16 O0, O1;
#pragma unroll
        for (int i = 0; i < 16; ++i) { O0[i] = 0.f; O1[i] = 0.f; }
        float mrun = -1e30f, lsum = 0.f;
        u32x4 sa[3], sb[3];
#pragma unroll
        for (int i = 0; i < 3; ++i) { sa[i] = (u32x4){0u, 0u, 0u, 0u}; sb[i] = (u32x4){0u, 0u, 0u, 0u}; }
#define AT_GLOAD(kt, slot) do { const int k0_ = (kt) == 0 ? 0 : 16 + 32 * ((kt) - 1); \
            if (c0k) { const int key = c0 / 12, part = c0 - key * 12; const size_t tok = tok0 + k0_ + key; \
                sa[slot] = part < 8 ? *(const u32x4*)(ka + tok * 512 + h * 64 + 8 * part) : *(const u32x4*)(kr + tok * 32 + 8 * (part - 8)); } \
            else { const int dv = c0 >> 2, part = c0 & 3; sa[slot] = *(const u32x4*)(vt + (size_t)(h * 64 + dv) * VTP + tok0 + k0_ + 8 * part); } \
            if (tid < 128) { const int dv = c1 >> 2, part = c1 & 3; sb[slot] = *(const u32x4*)(vt + (size_t)(h * 64 + dv) * VTP + tok0 + k0_ + 8 * part); } } while (0)
#define AT_LSTORE(buf, slot) do { LAS unsigned char* B_ = lds + (buf) * AT_BUF; \
            if (c0k) { const int key = c0 / 12, part = c0 - key * 12; *(LAS u32x4*)(B_ + key * (AT_KP * 2) + part * 16) = sa[slot]; } \
            else { const int dv = c0 >> 2, part = c0 & 3; LAS unsigned char* d = B_ + 32 * AT_KP * 2 + dv * (AT_VP * 2) + part * 16; *(LAS u32x2*)d = (u32x2){sa[slot].x, sa[slot].y}; *(LAS u32x2*)(d + 8) = (u32x2){sa[slot].z, sa[slot].w}; } \
            if (tid < 128) { const int dv = c1 >> 2, part = c1 & 3; LAS unsigned char* d = B_ + 32 * AT_KP * 2 + dv * (AT_VP * 2) + part * 16; *(LAS u32x2*)d = (u32x2){sb[slot].x, sb[slot].y}; *(LAS u32x2*)(d + 8) = (u32x2){sb[slot].z, sb[slot].w}; } } while (0)
#define AT_STEP(kt, slot) do { \
            if ((kt) + 3 <= ktmax) AT_GLOAD((kt) + 3, slot); \
            if ((kt) <= dkt) { \
                const LAS unsigned char* B = lds + ((kt) & 1) * AT_BUF; \
                f32x16 S; \
                _Pragma("unroll") for (int i = 0; i < 16; ++i) S[i] = 0.f; \
                _Pragma("unroll") for (int ks = 0; ks < 6; ++ks) { const bf16x8 kf = *(const LAS bf16x8*)(B + l31 * (AT_KP * 2) + ks * 32 + half * 16); S = __builtin_amdgcn_mfma_f32_32x32x16_bf16(kf, qf[ks], S, 0, 0, 0); } \
                bf16x8 vf[2][2]; \
                _Pragma("unroll") for (int rb = 0; rb < 2; ++rb) _Pragma("unroll") for (int kk = 0; kk < 2; ++kk) { const LAS unsigned char* vp = B + 32 * AT_KP * 2 + (rb * 32 + l31) * (AT_VP * 2) + (kk * 16 + half * 4) * 2; \
                        const u32x2 lo = *(const LAS u32x2*)vp, hi = *(const LAS u32x2*)(vp + 16); u32x4 w; w.x = lo.x; w.y = lo.y; w.z = hi.x; w.w = hi.y; vf[rb][kk] = __builtin_bit_cast(bf16x8, w); } \
                if ((kt) == 0) { _Pragma("unroll") for (int r = 8; r < 16; ++r) S[r] = -1e30f; } \
                if ((kt) == dkt) { _Pragma("unroll") for (int r = 0; r < 16; ++r) { const int kl = 8 * (r >> 2) + 4 * half + (r & 3); if (kl > l31) S[r] = -1e30f; } } \
                attn_softmax_pv(S, O0, O1, mrun, lsum, vf); \
            } \
            if ((kt) < ktmax) AT_LSTORE(((kt) + 1) & 1, ((slot) + 1) % 3); \
            __syncthreads(); } while (0)
        __syncthreads();
        AT_GLOAD(0, 0); AT_GLOAD(1, 1); AT_GLOAD(2, 2);
        AT_LSTORE(0, 0);
        __syncthreads();
        for (int kt = 0; kt <= ktmax; kt += 3) {
            AT_STEP(kt, 0);
            if (kt + 1 <= ktmax) AT_STEP(kt + 1, 1);
            if (kt + 2 <= ktmax) AT_STEP(kt + 2, 2);
        }
#undef AT_GLOAD
#undef AT_LSTORE
#undef AT_STEP
        const float ltot = lsum + __shfl_xor(lsum, 32);
        attn_store(oo, tokq, h, half, O0, O1, 1.f / ltot);
    }
    {
        const int wg = blockIdx.x * 8 + wid;
        if (wg < 128) {
            const int b = wg >> 3, h = wg & 7; const size_t tokq = (size_t)b * LSEQ + l31;
            bf16x8 qf[6], kf[6], vf[2][2];
#pragma unroll
            for (int ks = 0; ks < 6; ++ks) qf[ks] = *(const bf16x8*)(qa + tokq * 768 + h * 96 + ks * 16 + half * 8);
#pragma unroll
            for (int ks = 0; ks < 4; ++ks) kf[ks] = *(const bf16x8*)(ka + tokq * 512 + h * 64 + ks * 16 + half * 8);
#pragma unroll
            for (int ks = 0; ks < 2; ++ks) kf[4 + ks] = *(const bf16x8*)(kr + tokq * 32 + ks * 16 + half * 8);
#pragma unroll
            for (int rb = 0; rb < 2; ++rb)
#pragma unroll
                for (int kk = 0; kk < 2; ++kk) { const bf16_t* vp = vt + (size_t)(h * 64 + rb * 32 + l31) * VTP + (size_t)b * LSEQ + kk * 16 + half * 4;
                    const u32x2 lo = *(const u32x2*)vp, hi = *(const u32x2*)(vp + 8); u32x4 w; w.x = lo.x; w.y = lo.y; w.z = hi.x; w.w = hi.y; vf[rb][kk] = __builtin_bit_cast(bf16x8, w); }
            f32x16 S, O0, O1;
#pragma unroll
            for (int i = 0; i < 16; ++i) { S[i] = 0.f; O0[i] = 0.f; O1[i] = 0.f; }
#pragma unroll
            for (int ks = 0; ks < 6; ++ks) S = __builtin_amdgcn_mfma_f32_32x32x16_bf16(kf[ks], qf[ks], S, 0, 0, 0);
#pragma unroll
            for (int r = 0; r < 16; ++r) { const int kl = 8 * (r >> 2) + 4 * half + (r & 3); if (kl > l31) S[r] = -1e30f; }
            float mrun = -1e30f, lsum = 0.f;
            attn_softmax_pv(S, O0, O1, mrun, lsum, vf);
            const float ltot = lsum + __shfl_xor(lsum, 32);
            if (l31 < 16) attn_store(oo, tokq, h, half, O0, O1, 1.f / ltot);
        }
    }
    __syncthreads();
}

DI void s5_scan(KP p, int gtid_, int gthreads) {
    p = kp_launder(p);
    const int gtid = blockIdx.x * 128 + otid(); gthreads = ogrid() * 128;
    const float* __restrict__ ebuf = (const float*)(p->ws + O_EBUF); const float* a16 = (const float*)(p->ws + W_A16);
    bf16_t* __restrict__ ug = (bf16_t*)((unsigned char*)p->out + X_UG);
    for (int idx = gtid; idx < 32768; idx += gthreads) {
        const int n = idx & 63, b = (idx >> 6) & 15, g = idx >> 10;
        const float ar = a16[(g * 64 + n) * 2], ai = a16[(g * 64 + n) * 2 + 1];
        float xr = 0.f, xi = 0.f;
        const float* e = ebuf + ((size_t)g * LSEQ + b * NCHK) * 128 + n;
        bf16_t* x = ug + ((size_t)g * SROWS + b * NCHK) * 384 + 256 + n;
        float er[8], ei[8], fr_[8], fi_[8];
#pragma unroll
        for (int i = 0; i < 8; ++i) { er[i] = e[(size_t)i * 128]; ei[i] = e[(size_t)i * 128 + 64]; }
        for (int ch0 = 0; ch0 < NCHK; ch0 += 8) {
#pragma unroll
            for (int i = 0; i < 8; ++i) { const int ch = ch0 + 8 + i; const bool ok = ch < NCHK; fr_[i] = ok ? e[(size_t)ch * 128] : 0.f; fi_[i] = ok ? e[(size_t)ch * 128 + 64] : 0.f; }
#pragma unroll
            for (int i = 0; i < 8; ++i) { const int ch = ch0 + i;
                if (ch < NCHK) { x[(size_t)ch * 384] = f2bf(xr); x[(size_t)ch * 384 + 64] = f2bf(xi);
                    const float nr = ar * xr - ai * xi + er[i], ni = ar * xi + ai * xr + ei[i]; xr = nr; xi = ni; } }
#pragma unroll
            for (int i = 0; i < 8; ++i) { er[i] = fr_[i]; ei[i] = fi_[i]; }
        }
    }
}

DI void hg_setup(KP p, int l, LAS unsigned char* L, bool valid, int row0, int clen, int h, int t2) {
    LAS float* cum = (LAS float*)(L + HG_CUM); LAS bf16_t* kraw = (LAS bf16_t*)(L + HG_KRAW); LAS bf16_t* vT = (LAS bf16_t*)(L + HG_VT);
    const bf16_t* zhg = (const bf16_t*)(p->ws + O_ZHG);
    {
        const int kc = t2 & 15;
        float lb[8];
#pragma unroll
        for (int i = 0; i < 8; ++i) lb[i] = 0.f;
        if (l == 1) { const float* lg = (const float*)p->in[19] + h * 128 + 8 * kc;
#pragma unroll
            for (int i = 0; i < 8; ++i) { const float x0 = lg[i], x1 = lg[512 + i]; const float mxx = fmaxf(x0, x1); const float e0 = __expf(x0 - mxx), e1 = __expf(x1 - mxx); lb[i] = e1 / (e0 + e1); } }
        u32x4 zw[4];
#pragma unroll
        for (int i = 0; i < 4; ++i) { const int s = (t2 >> 4) + 16 * i; zw[i] = (u32x4){0u, 0u, 0u, 0u};
            if (valid && s < clen) zw[i] = *(const u32x4*)(zhg + (size_t)(row0 + s) * 2048 + 512 + h * 128 + 8 * kc); }
        u32x4 vw[4];
#pragma unroll
        for (int i = 0; i < 4; ++i) { const int q = t2 + 256 * i, s = q & 63, vc = q >> 6; vw[i] = (u32x4){0u, 0u, 0u, 0u};
            if (valid && s < clen) vw[i] = *(const u32x4*)(zhg + (size_t)(row0 + s) * 2048 + 1024 + h * 128 + 8 * vc); }
#pragma unroll
        for (int i = 0; i < 4; ++i) {
            const int s = (t2 >> 4) + 16 * i; const bool in = valid && s < clen;
            const float z[8] = {bflo(zw[i].x), bfhi(zw[i].x), bflo(zw[i].y), bfhi(zw[i].y), bflo(zw[i].z), bfhi(zw[i].z), bflo(zw[i].w), bfhi(zw[i].w)};
            float lf[8], kk[8];
#pragma unroll
            for (int e = 0; e < 8; ++e) { const float sg = sigm(z[e]), f = lb[e] + (1.f - lb[e]) * sg; lf[e] = in ? __logf(fmaxf(f, 1e-6f)) : 0.f; kk[e] = in ? (1.f - lb[e]) * (1.f - sg) : 0.f; }
#pragma unroll
            for (int e = 0; e < 8; e += 2) *(LAS f32x2*)(cum + s * CUMP + 8 * kc + e) = (f32x2){lf[e], lf[e + 1]};
            u32x4 w; w.x = pk2(kk[0], kk[1]); w.y = pk2(kk[2], kk[3]); w.z = pk2(kk[4], kk[5]); w.w = pk2(kk[6], kk[7]);
            *(LAS u32x4*)(kraw + s * KRP + 8 * kc) = w;
        }
#pragma unroll
        for (int i = 0; i < 4; ++i) { const int q = t2 + 256 * i, s = q & 63, vc = q >> 6;
            const unsigned ww[4] = {vw[i].x, vw[i].y, vw[i].z, vw[i].w};
#pragma unroll
            for (int e = 0; e < 4; ++e) { vT[(8 * vc + 2 * e) * VTPP + s] = (bf16_t)(ww[e] & 0xffffu); vT[(8 * vc + 2 * e + 1) * VTPP + s] = (bf16_t)(ww[e] >> 16); } }
    }
    __syncthreads();
    if (t2 < 128) {
        float c = 0.f;
#pragma unroll 16
        for (int s = 0; s < 64; ++s) { c += cum[s * CUMP + t2]; cum[s * CUMP + t2] = c; }
    }
}
DI void hg_unit(int uidx, int& bh, int& c, int& row0, int& clen) { bh = uidx / HGC; c = uidx - bh * HGC; const int b = bh >> 2; row0 = b * LSEQ + (c == 0 ? 0 : 16 + 64 * (c - 1)); clen = c == 0 ? 16 : 64; }

DI void hg1_phase(KP p, int l, LAS unsigned char* lds) {
    p = kp_launder(p);
    const int tid = otid(), hw = tid >> 8, t2 = tid & 255, w4 = (tid >> 6) & 3, lane = tid & 63, fr = lane & 15, fq = lane >> 4;
    LAS unsigned char* L = lds + hw * HG_HALF;
    LAS float* cum = (LAS float*)(L + HG_CUM); LAS bf16_t* kraw = (LAS bf16_t*)(L + HG_KRAW); LAS bf16_t* vT = (LAS bf16_t*)(L + HG_VT);
    bf16_t* sloc = (bf16_t*)((unsigned char*)p->out + X_SLOC); float* dec = (float*)(p->ws + O_HGDEC);
    const int npairs = (64 * HGC + 1) / 2;
    for (int it = 0; it * (int)gridDim.x < npairs; ++it) {
        const int uidx = (it * gridDim.x + blockIdx.x) * 2 + hw; const bool valid = uidx < 64 * HGC;
        int bh, c, row0, clen; hg_unit(valid ? uidx : 0, bh, c, row0, clen); const int h = bh & 3;
        __syncthreads();
        hg_setup(p, l, L, valid, row0, clen, h, t2);
        __syncthreads();
        if (valid) {
            bf16x8 bfr[2][2];
#pragma unroll
            for (int nbi = 0; nbi < 2; ++nbi)
#pragma unroll
                for (int ks = 0; ks < 2; ++ks) {
                    const int dk = 16 * (2 * w4 + nbi) + fr; const float last = cum[63 * CUMP + dk]; float v[8];
#pragma unroll
                    for (int i = 0; i < 8; ++i) { const int s = 32 * ks + 8 * fq + i; v[i] = bf2f(kraw[s * KRP + dk]) * __expf(last - cum[s * CUMP + dk]); }
                    u32x4 w; w.x = pk2(v[0], v[1]); w.y = pk2(v[2], v[3]); w.z = pk2(v[4], v[5]); w.w = pk2(v[6], v[7]); bfr[nbi][ks] = __builtin_bit_cast(bf16x8, w);
                }
            bf16_t* dst = sloc + (size_t)(bh * HGC + c) * 128 * 128;
#pragma unroll
            for (int mb = 0; mb < 8; ++mb) {
                f32x4 a0 = {0.f, 0.f, 0.f, 0.f}, a1 = {0.f, 0.f, 0.f, 0.f};
#pragma unroll
                for (int ks = 0; ks < 2; ++ks) {
                    const bf16x8 af = *(const LAS bf16x8*)(vT + (16 * mb + fr) * VTPP + 32 * ks + 8 * fq);
                    a0 = __builtin_amdgcn_mfma_f32_16x16x32_bf16(af, bfr[0][ks], a0, 0, 0, 0);
                    a1 = __builtin_amdgcn_mfma_f32_16x16x32_bf16(af, bfr[1][ks], a1, 0, 0, 0);
                }
#pragma unroll
                for (int j = 0; j < 4; ++j) { const int dv = 16 * mb + 4 * fq + j;
                    dst[(size_t)dv * 128 + 16 * (2 * w4) + fr] = f2bf(a0[j]); dst[(size_t)dv * 128 + 16 * (2 * w4 + 1) + fr] = f2bf(a1[j]); }
            }
            if (t2 < 128) dec[(size_t)(bh * HGC + c) * 128 + t2] = __expf(cum[63 * CUMP + t2]);
        }
    }
    __syncthreads();
}

DI void hg2_phase(KP p, int gtid_, int gthreads) {
    p = kp_launder(p);
    const int gtid = blockIdx.x * 512 + otid(); gthreads = ogrid() * 512;
    bf16_t* sloc = (bf16_t*)((unsigned char*)p->out + X_SLOC); const float* dec = (const float*)(p->ws + O_HGDEC);
    for (int idx = gtid; idx < 64 * 128 * 16; idx += gthreads) {
        const int k8 = idx & 15, dv = (idx >> 4) & 127, bh = idx >> 11;
        float S[8];
#pragma unroll
        for (int i = 0; i < 8; ++i) S[i] = 0.f;
        bf16_t* base = sloc + ((size_t)(bh * HGC) * 128 + dv) * 128 + k8 * 8; const float* dbase = dec + (size_t)(bh * HGC) * 128 + k8 * 8;
        u32x4 wA[4], wB[4]; f32x4 dA[4][2], dB[4][2];
#pragma unroll
        for (int i = 0; i < 4; ++i) { wA[i] = *(const u32x4*)(base + (size_t)i * 16384); dA[i][0] = *(const f32x4*)(dbase + i * 128); dA[i][1] = *(const f32x4*)(dbase + i * 128 + 4); }
        for (int c0 = 0; c0 < HGC; c0 += 4) {
#pragma unroll
            for (int i = 0; i < 4; ++i) { const int c = c0 + 4 + i; if (c < HGC) { wB[i] = *(const u32x4*)(base + (size_t)c * 16384); dB[i][0] = *(const f32x4*)(dbase + c * 128); dB[i][1] = *(const f32x4*)(dbase + c * 128 + 4); } }
#pragma unroll
            for (int i = 0; i < 4; ++i) { const int c = c0 + i;
                if (c < HGC) {
                    u32x4 o; o.x = pk2(S[0], S[1]); o.y = pk2(S[2], S[3]); o.z = pk2(S[4], S[5]); o.w = pk2(S[6], S[7]);
                    *(u32x4*)(base + (size_t)c * 16384) = o;
                    const u32x4 w = wA[i]; const f32x4 d0 = dA[i][0], d1 = dA[i][1];
                    S[0] = d0[0] * S[0] + bflo(w.x); S[1] = d0[1] * S[1] + bfhi(w.x); S[2] = d0[2] * S[2] + bflo(w.y); S[3] = d0[3] * S[3] + bfhi(w.y);
                    S[4] = d1[0] * S[4] + bflo(w.z); S[5] = d1[1] * S[5] + bfhi(w.z); S[6] = d1[2] * S[6] + bflo(w.w); S[7] = d1[3] * S[7] + bfhi(w.w);
                } }
#pragma unroll
            for (int i = 0; i < 4; ++i) { wA[i] = wB[i]; dA[i][0] = dB[i][0]; dA[i][1] = dB[i][1]; }
        }
    }
}

DI void hg3_phase(KP p, int l, LAS unsigned char* lds) {
    p = kp_launder(p);
    const int tid = otid(), hw = tid >> 8, t2 = tid & 255, I = __builtin_amdgcn_readfirstlane((tid >> 6) & 3), lane = tid & 63, fr = lane & 15, fq = lane >> 4;
    LAS unsigned char* L = lds + hw * HG_HALF;
    LAS float* cum = (LAS float*)(L + HG_CUM); LAS bf16_t* kraw = (LAS bf16_t*)(L + HG_KRAW); LAS bf16_t* vT = (LAS bf16_t*)(L + HG_VT);
    const bf16_t* zhg = (const bf16_t*)(p->ws + O_ZHG); const bf16_t* st = (const bf16_t*)((unsigned char*)p->out + X_SLOC);
    bf16_t* hgout = (bf16_t*)(p->ws + O_HGOUT); const float* onorm = (const float*)p->in[20] + (size_t)l * 512;
    const int npairs = (64 * HGC + 1) / 2;
    for (int it = 0; it * (int)gridDim.x < npairs; ++it) {
        const int uidx = (it * gridDim.x + blockIdx.x) * 2 + hw; const bool valid = uidx < 64 * HGC;
        int bh, c, row0, clen; hg_unit(valid ? uidx : 0, bh, c, row0, clen); const int h = bh & 3;
        __syncthreads();
        hg_setup(p, l, L, valid, row0, clen, h, t2);
        __syncthreads();
        const int t = 16 * I + fr; const bool tv = valid && t < clen; const size_t row = (size_t)row0 + t;
        if (valid && 16 * I < clen) {
            bf16x8 qt[4], q2[4]; float Rr[4][8];
#pragma unroll
            for (int ks = 0; ks < 4; ++ks) {
                u32x4 qw = {0u, 0u, 0u, 0u}; if (tv) qw = *(const u32x4*)(zhg + row * 2048 + h * 128 + 32 * ks + 8 * fq);
                float q[8] = {bflo(qw.x), bfhi(qw.x), bflo(qw.y), bfhi(qw.y), bflo(qw.z), bfhi(qw.z), bflo(qw.w), bfhi(qw.w)};
                float a[8], bq[8];
#pragma unroll
                for (int i = 0; i < 8; ++i) { const int k = 32 * ks + 8 * fq + i; const float ct = cum[t * CUMP + k]; const float rr = I > 0 ? cum[(16 * I - 1) * CUMP + k] : 0.f; Rr[ks][i] = rr;
                    a[i] = q[i] * __expf(ct - rr); bq[i] = q[i] * __expf(ct); }
                u32x4 w; w.x = pk2(a[0], a[1]); w.y = pk2(a[2], a[3]); w.z = pk2(a[4], a[5]); w.w = pk2(a[6], a[7]); qt[ks] = __builtin_bit_cast(bf16x8, w);
                w.x = pk2(bq[0], bq[1]); w.y = pk2(bq[2], bq[3]); w.z = pk2(bq[4], bq[5]); w.w = pk2(bq[6], bq[7]); q2[ks] = __builtin_bit_cast(bf16x8, w);
            }
            f32x4 PT[4];
#pragma unroll
            for (int J = 0; J < 4; ++J) {
                PT[J] = (f32x4){0.f, 0.f, 0.f, 0.f};
                if (J <= I) {
#pragma unroll
                    for (int ks = 0; ks < 4; ++ks) {
                        const int s = 16 * J + fr; const u32x4 kw = *(const LAS u32x4*)(kraw + s * KRP + 32 * ks + 8 * fq);
                        float kk[8] = {bflo(kw.x), bfhi(kw.x), bflo(kw.y), bfhi(kw.y), bflo(kw.z), bfhi(kw.z), bflo(kw.w), bfhi(kw.w)};
#pragma unroll
                        for (int i = 0; i < 8; ++i) kk[i] *= __expf(Rr[ks][i] - cum[s * CUMP + 32 * ks + 8 * fq + i]);
                        u32x4 w; w.x = pk2(kk[0], kk[1]); w.y = pk2(kk[2], kk[3]); w.z = pk2(kk[4], kk[5]); w.w = pk2(kk[6], kk[7]);
                        PT[J] = __builtin_amdgcn_mfma_f32_16x16x32_bf16(__builtin_bit_cast(bf16x8, w), qt[ks], PT[J], 0, 0, 0);
                    }
                    if (J == I) {
#pragma unroll
                        for (int j = 0; j < 4; ++j) if (4 * fq + j > fr) PT[J][j] = 0.f;
                    }
                }
            }
            f32x4 acc[8];
#pragma unroll
            for (int mb = 0; mb < 8; ++mb) acc[mb] = (f32x4){0.f, 0.f, 0.f, 0.f};
#pragma unroll
            for (int pr = 0; pr < 2; ++pr) {
                const int J0 = 2 * pr;
                if (J0 <= I) {
                    u32x4 w; w.x = pk2(PT[J0][0], PT[J0][1]); w.y = pk2(PT[J0][2], PT[J0][3]); w.z = pk2(PT[J0 + 1][0], PT[J0 + 1][1]); w.w = pk2(PT[J0 + 1][2], PT[J0 + 1][3]);
                    const bf16x8 pf = __builtin_bit_cast(bf16x8, w);
#pragma unroll
                    for (int mb = 0; mb < 8; ++mb) {
                        const LAS bf16_t* vp = vT + (16 * mb + fr) * VTPP + 16 * J0 + 4 * fq;
                        const u32x2 lo = *(const LAS u32x2*)vp, hi = *(const LAS u32x2*)(vp + 16);
                        u32x4 a; a.x = lo.x; a.y = lo.y; a.z = hi.x; a.w = hi.y;
                        acc[mb] = __builtin_amdgcn_mfma_f32_16x16x32_bf16(__builtin_bit_cast(bf16x8, a), pf, acc[mb], 0, 0, 0);
                    }
                }
            }
            if (c > 0) {
                const bf16_t* sp = st + (size_t)(bh * HGC + c) * 128 * 128;
#pragma unroll
                for (int mb = 0; mb < 8; ++mb)
#pragma unroll
                    for (int ks = 0; ks < 4; ++ks) {
                        const bf16x8 af = *(const bf16x8*)(sp + (size_t)(16 * mb + fr) * 128 + 32 * ks + 8 * fq);
                        acc[mb] = __builtin_amdgcn_mfma_f32_16x16x32_bf16(af, q2[ks], acc[mb], 0, 0, 0);
                    }
            }
            float sq = 0.f;
#pragma unroll
            for (int mb = 0; mb < 8; ++mb) sq += acc[mb][0] * acc[mb][0] + acc[mb][1] * acc[mb][1] + acc[mb][2] * acc[mb][2] + acc[mb][3] * acc[mb][3];
            sq += __shfl_xor(sq, 16); sq += __shfl_xor(sq, 32);
            const float rs = rsqrtf(sq * (1.f / 128.f) + 1e-6f);
            if (tv) {
#pragma unroll
                for (int mb = 0; mb < 8; ++mb) {
                    const int dv = 16 * mb + 4 * fq;
                    const u32x2 gw = *(const u32x2*)(zhg + row * 2048 + 1536 + h * 128 + dv);
                    const f32x4 on = *(const f32x4*)(onorm + h * 128 + dv);
                    const float g0 = bflo(gw.x), g1 = bfhi(gw.x), g2 = bflo(gw.y), g3 = bfhi(gw.y);
                    u32x2 w; w.x = pk2(acc[mb][0] * rs * on[0] * g0 * sigm(g0), acc[mb][1] * rs * on[1] * g1 * sigm(g1));
                    w.y = pk2(acc[mb][2] * rs * on[2] * g2 * sigm(g2), acc[mb][3] * rs * on[3] * g3 * sigm(g3));
                    *(u32x2*)(hgout + row * 512 + h * 128 + dv) = w;
                }
            }
        }
    }
    __syncthreads();
}

#define XB_TMO      128
#define XB_XCNT(j)  (256  + 64 * (j))
#define XB_XSUB(j)  (1280 + 64 * (j))
#define XB_XGEN(j)  (2304 + 64 * (j))
#define XB_TOP      3328
#define XB_TOPGEN   3392
#define XCD_BAR_WORDS 3456
#define XB_SPIN_CAP (1u << 18)

__device__ __forceinline__ unsigned xb_ld(unsigned* p)              { return __hip_atomic_load(p, __ATOMIC_RELAXED, __HIP_MEMORY_SCOPE_AGENT); }
__device__ __forceinline__ unsigned xb_add(unsigned* p, unsigned v) { return __hip_atomic_fetch_add(p, v, __ATOMIC_RELAXED, __HIP_MEMORY_SCOPE_AGENT); }
__device__ __forceinline__ unsigned xb_xcc_id() { return (unsigned)__builtin_amdgcn_s_getreg((3 << 11) | 20) & 0xFu; }
#define XB_SPIN(cond, bar) do { unsigned _sp = 0; while (cond) { __builtin_amdgcn_s_sleep(1); \
    if ((++_sp & 255u) == 0u) { if (xb_ld(&(bar)[XB_TMO])) break; if (_sp > XB_SPIN_CAP) { atomicAdd(&(bar)[XB_TMO], 1u); break; } } } } while (0)

struct XcdBarrier {
    unsigned* bar; unsigned x;
    volatile LAS unsigned* st;
};

__device__ __forceinline__ XcdBarrier xcd_barrier_post(unsigned* bar, volatile LAS unsigned* st) {
    XcdBarrier b; b.bar = bar; b.x = xb_xcc_id(); b.st = st;
    if (threadIdx.x == 0) (void)xb_add(&bar[XB_XCNT(b.x)], 1u);
    return b;
}
__device__ __forceinline__ void xcd_barrier_complete(unsigned* bar, unsigned x, unsigned& nloc, unsigned& nx) {
    const unsigned G = gridDim.x * gridDim.y * gridDim.z;
    unsigned sum, cnt, mine, sp = 0u;
    for (;;) {
        sum = 0u; cnt = 0u; mine = 0u;
#pragma unroll
        for (unsigned j = 0; j < 16; ++j) { const unsigned c = xb_ld(&bar[XB_XCNT(j)]); sum += c; cnt += (c > 0u) ? 1u : 0u; mine = (j == x) ? c : mine; }
        if (sum == G) break;
        __builtin_amdgcn_s_sleep(1);
        if ((++sp & 255u) == 0u) { if (xb_ld(&bar[XB_TMO])) break; if (sp > XB_SPIN_CAP) { atomicAdd(&bar[XB_TMO], 1u); break; } }
    }
    nloc = mine > 0u ? mine : 1u; nx = cnt > 0u ? cnt : 1u;
}

__device__ __forceinline__ void xcd_barrier(const XcdBarrier& b) {
    asm volatile("s_waitcnt vmcnt(0)" ::: "memory");
    __syncthreads();
    if (threadIdx.x == 0) {
        unsigned* bar = b.bar;
        __builtin_amdgcn_s_waitcnt(0);
        unsigned nloc = b.st[0], nx = b.st[1];
        if (nloc == 0u) { xcd_barrier_complete(bar, b.x, nloc, nx); b.st[0] = nloc; b.st[1] = nx; }
        const unsigned old = xb_add(&bar[XB_XSUB(b.x)], 1u);
        const unsigned gen = old / nloc;
        if (old + 1u == (gen + 1u) * nloc) {
            __builtin_amdgcn_fence(__ATOMIC_RELEASE, "agent");
            asm volatile("s_waitcnt vmcnt(0)" ::: "memory");
            const unsigned og = xb_add(&bar[XB_TOP], 1u);
            const unsigned tg = og / nx;
            if (og + 1u == (tg + 1u) * nx) xb_add(&bar[XB_TOPGEN], 1u);
            else XB_SPIN(xb_ld(&bar[XB_TOPGEN]) == tg, bar);
            __builtin_amdgcn_fence(__ATOMIC_ACQUIRE, "agent");
            xb_add(&bar[XB_XGEN(b.x)], 1u);
            asm volatile("s_waitcnt vmcnt(0)" ::: "memory");
        } else {
            XB_SPIN(xb_ld(&bar[XB_XGEN(b.x)]) == gen, bar);
            __builtin_amdgcn_fence(__ATOMIC_ACQUIRE, "agent");
            asm volatile("s_waitcnt vmcnt(0)" ::: "memory");
        }
    }
    __syncthreads();
}


__global__ void __launch_bounds__(512, 2) fwd_megakernel(Params p_args) {
    KP p = kparams();
    extern __shared__ __attribute__((aligned(16))) unsigned char smem[];
    LAS unsigned char* lds = (LAS unsigned char*)smem;
    cg::grid_group grid = cg::this_grid();
    const int tid = threadIdx.x, wid = __builtin_amdgcn_readfirstlane(tid >> 6), lane = tid & 63;
    const int G = gridDim.x, c = blockIdx.x, gtid = c * 512 + tid, gthreads = G * 512, gwave = c * 8 + wid, nwaves = G * 8;
    unsigned char* ws = p->ws; unsigned char* xo = (unsigned char*)p->out;
    float* hres = (float*)(ws + O_HRES); float* ssq = (float*)(ws + O_SSQ);
    const float* cosT = (const float*)(ws + O_COS); const float* sinT = (const float*)(ws + O_SIN);

    if (c == 0) for (int i = tid; i < XCD_BAR_WORDS; i += 512) __hip_atomic_store((unsigned*)(p->ws + O_BAR) + i, 0u, __ATOMIC_RELAXED, __HIP_MEMORY_SCOPE_AGENT);
    if (tid < 2) ((volatile LAS unsigned*)(lds + LDS_BARST))[tid] = 0u;
#if PH_PRO
    convert_weights(p, 0, 0, lds);
    convert_weights(p, 0, 1, lds);
    if (c >= G - 32) s5_build(p, 0, c - (G - 32), lds);
#endif
    ln_rows(p, 0, (const float*)p->in[3], (const float*)p->in[4], gwave, nwaves, lane);
    for (int idx = c * 512 + otid(); idx < T * 16; idx += ogrid() * 512) {
        const int r = idx >> 4, i = idx & 15, b = r / LSEQ, tt = r - b * LSEQ;
        const int pos = tt < 16 ? tt : ((const int*)p->in[1])[b * 2048 + tt - 16] + 16;
        const float inv = expf(-(float)i * (1.f / 16.f) * 9.210340371976184f);
        float s, cc; sincosf((float)pos * inv, &s, &cc);
        ((float*)(ws + O_COS))[idx] = cc; ((float*)(ws + O_SIN))[idx] = s;
    }
    for (int idx = c * 512 + otid(); idx < 2 * T; idx += ogrid() * 512) ssq[idx] = 0.f;
    for (int idx = c * 512 + otid(); idx < 8 * T; idx += ogrid() * 512) ((float*)(ws + O_STATS))[idx] = 0.f;
    grid.sync();
    const XcdBarrier xbar = xcd_barrier_post((unsigned*)(p->ws + O_BAR), (volatile LAS unsigned*)(lds + LDS_BARST));
#define WSP unsigned char* ws = kp_launder(p)->ws; unsigned char* xo = (unsigned char*)kp_launder(p)->out; (void)xo;
#define STATS(slot) ((float*)(ws + O_STATS) + (size_t)(slot) * T * 2)
#define COLV(off) ((const float*)(ws + O_COLV) + (off))

    for (int l = 0; l < 2; ++l) {
        { WSP
          pg8::SchedGrid S{(const char*)(ws + O_HBF), (const char*)(ws + W_WIN), 1024, 1024, 16, 129, 13, ogrid(), obid()};
          EpiA E{(bf16_t*)(xo + X_UG), (bf16_t*)(ws + O_ZHG), (bf16_t*)(ws + O_CQKV), (bf16_t*)(ws + O_KR), (float*)(ws + O_SSQ), (const float*)(ws + O_COS), (const float*)(ws + O_SIN),
                 l > 0 ? STATS(2 * l - 1) : (const float*)nullptr, COLV(CV_IN), COLV(CV_IN + 3328)};
          pg8::gemm_phase(lds, S, E);
          if (l == 1) convert_weights(p, 1, 1, lds); }
        xcd_barrier(xbar);
        { WSP
          EpiB E{(bf16_t*)(xo + X_QA), (bf16_t*)(ws + O_KA), (bf16_t*)(ws + O_VT), (float*)(ws + O_EBUF), (const float*)(ws + O_SSQ), (const float*)(ws + O_COS), (const float*)(ws + O_SIN)};
          pg8::gemm_phase(lds, SchedB{(const char*)(ws + O_CQKV), (const char*)(ws + W_WUQ), 512, 256, 4, 0, ogrid(), obid()}, E);
          pg8::gemm_phase(lds, SchedB{(const char*)(ws + O_CQKV) + 512, (const char*)(ws + W_WK), 512, 256, 4, 1, ogrid(), obid()}, E);
          pg8::gemm_phase(lds, SchedB{(const char*)(ws + W_WV), (const char*)(ws + O_CQKV) + 512, 256, 512, 4, 2, ogrid(), obid()}, E);
          pg8::gemm_phase(lds, SchedS5{(const char*)(xo + X_UG), (const char*)(ws + W_MB), 384, 256, 4, 3, ogrid(), obid()}, E); }
        xcd_barrier(xbar);
        if (otid() < 128) s5_scan(p, 0, G * 128);
        attention_phase(p, lds);
        { float* ssq = (float*)(kp_launder(p)->ws + O_SSQ); for (int idx = obid() * 512 + otid(); idx < 2 * T; idx += ogrid() * 512) ssq[idx] = 0.f; }
        xcd_barrier(xbar);
        { WSP
          pg8::gemm_phase(lds, SchedS5{(const char*)(xo + X_UG), (const char*)(ws + W_MD), 384, 384, 6, 0, ogrid(), obid()}, EpiS5Y{(bf16_t*)(ws + O_YGELU)}); }
        hg1_phase(p, l, lds);
        xcd_barrier(xbar);
        { WSP
          pg8::SchedGrid S{(const char*)(ws + O_YGELU), (const char*)(ws + W_WGLU), 512, 512, 8, 129, 2, ogrid(), obid()};
          pg8::gemm_phase(lds, S, EpiGlu{(const bf16_t*)(ws + O_YGELU), (bf16_t*)(ws + O_S5OUT)}); }
        hg2_phase(p, gtid, gthreads);
        xcd_barrier(xbar);
        hg3_phase(p, l, lds);
        xcd_barrier(xbar);
        { WSP
          EpiF E{(bf16_t*)(ws + O_GATEB), (bf16_t*)(ws + O_MIXED), l > 0 ? STATS(2 * l - 1) : (const float*)nullptr, COLV(CV_GATE), COLV(CV_GATE + 3072)};
          const char* brp[3] = {(const char*)(ws + O_O), (const char*)(ws + O_S5OUT), (const char*)(ws + O_HGOUT)};
#pragma unroll
          for (int br = 0; br < 3; ++br) {
              pg8::gemm_phase(lds, SchedF{(const char*)(ws + O_HBF), (const char*)(ws + W_WGATE) + (size_t)br * 1024 * 1024 * 2, 1024, 1024, 16, 2 * br, ogrid(), obid()}, E);
              pg8::gemm_phase(lds, SchedF{brp[br], (const char*)(ws + W_WBR) + (size_t)br * 1024 * 512 * 2, 512, 512, 8, 2 * br + 1, ogrid(), obid()}, E);
          } }
        xcd_barrier(xbar);
        { WSP
          pg8::SchedGrid S{(const char*)(ws + O_MIXED), (const char*)(ws + W_WOUT), 1024, 1024, 16, 129, 4, ogrid(), obid()};
          EpiRes E{(float*)(ws + O_HRES), (bf16_t*)(ws + O_HBF), l > 0 ? STATS(2 * l - 1) : (const float*)nullptr, (const float*)kp_launder(p)->in[30] + (l - 1) * 1024, (const float*)kp_launder(p)->in[31] + (l - 1) * 1024, STATS(2 * l)};
          pg8::gemm_phase(lds, S, E); }
        xcd_barrier(xbar);
        { WSP
          pg8::SchedGrid S{(const char*)(ws + O_HBF), (const char*)(ws + W_WGU), 1024, 1024, 16, 129, 22, ogrid(), obid()};
          pg8::gemm_phase(lds, S, EpiFfn1{(bf16_t*)(ws + O_HFF), STATS(2 * l), COLV(CV_GU), COLV(CV_GU + 5632)});
          if (l == 0) { convert_weights(p, 1, 0, lds); if (obid() >= ogrid() - 32) s5_build(p, 1, obid() - (ogrid() - 32), lds); } }
        xcd_barrier(xbar);
        { WSP
          pg8::SchedGrid S{(const char*)(ws + O_HFF), (const char*)(ws + W_WD), DFF, DFF, 44, 129, 4, ogrid(), obid()};
          EpiRes E{(float*)(ws + O_HRES), (bf16_t*)(ws + O_HBF), STATS(2 * l), (const float*)kp_launder(p)->in[25] + l * 1024, (const float*)kp_launder(p)->in[26] + l * 1024, STATS(2 * l + 1)};
          pg8::gemm_phase(lds, S, E); }
        xcd_barrier(xbar);
    }
    ln_rows(p, 2, (const float*)p->in[30] + 1024, (const float*)p->in[31] + 1024, gwave, nwaves, lane);
}

extern "C" void kernel_launch(void* const* d_in, const int* in_sizes, int n_in, void* d_out, int out_size, void* d_ws, size_t ws_size, hipStream_t stream) {
    static int grid_blocks = 0;
    if (!grid_blocks) {
        int dev = 0, cus = 0, per_cu = 0;
        hipGetDevice(&dev);
        hipDeviceGetAttribute(&cus, hipDeviceAttributeMultiprocessorCount, dev);
        hipFuncSetAttribute((const void*)fwd_megakernel, hipFuncAttributeMaxDynamicSharedMemorySize, LDS_BYTES);
        hipOccupancyMaxActiveBlocksPerMultiprocessor(&per_cu, (const void*)fwd_megakernel, 512, LDS_BYTES);
        if (per_cu < 1) per_cu = 1;
        if (per_cu > 1) per_cu = 1;
        grid_blocks = cus * per_cu;
        if (ws_size < O_WSEND) fprintf(stderr, "kernel_launch: workspace too small: %zu < %zu\n", ws_size, (size_t)O_WSEND);
    }
    Params p{};
    for (int i = 0; i < 32; ++i) p.in[i] = d_in[i];
    p.out = (float*)d_out; p.ws = (unsigned char*)d_ws;
    void* args[] = {&p};
    hipError_t e = hipLaunchCooperativeKernel((const void*)fwd_megakernel, dim3(grid_blocks), dim3(512), args, LDS_BYTES, stream);
    if (e != hipSuccess) fprintf(stderr, "cooperative launch failed: %s (grid %d)\n", hipGetErrorString(e), grid_blocks);
}
```

```cpp
#include <hip/hip_runtime.h>
#include <hip/hip_cooperative_groups.h>
#include <cstdint>
#include <cstdio>
namespace cg = cooperative_groups;
#ifndef DBL_C
#define DBL_C 0
#endif
#ifndef DBL_HG
#define DBL_HG 0
#endif
#ifndef PH_PRO
#define PH_PRO 1
#endif
#ifndef PH_A
#define PH_A 1
#endif
#ifndef PH_B
#define PH_B 1
#endif
#ifndef PH_C
#define PH_C 1
#endif
#ifndef PH_D
#define PH_D 1
#endif
#ifndef PH_HG1
#define PH_HG1 1
#endif
#ifndef PH_E
#define PH_E 1
#endif
#ifndef PH_HG3
#define PH_HG3 1
#endif
#ifndef PH_F
#define PH_F 1
#endif
#ifndef PH_G
#define PH_G 1
#endif
#ifndef PH_I
#define PH_I 1
#endif
#ifndef PH_J
#define PH_J 1
#endif

#define DI __device__ __forceinline__
#define LAS __attribute__((address_space(3)))
typedef unsigned short bf16_t;
typedef short bf16x8 __attribute__((ext_vector_type(8)));
typedef float f32x4 __attribute__((ext_vector_type(4)));
typedef float f32x2 __attribute__((ext_vector_type(2)));
typedef float f32x16 __attribute__((ext_vector_type(16)));
typedef unsigned u32x4 __attribute__((ext_vector_type(4)));
typedef unsigned u32x2 __attribute__((ext_vector_type(2)));
typedef __bf16 bfv2 __attribute__((ext_vector_type(2)));

constexpr int NB = 16, LSEQ = 2064, T = NB * LSEQ, DM = 1024, DFF = 2816;
constexpr int NCHK = 129;
constexpr int SROWS = 2304;
constexpr int HGC = 33;
constexpr float ALPHA = 1.41421356237309515f;
constexpr float QSCALE = 0.10206207261596575f * 1.4426950408889634f;

constexpr size_t al256(size_t x) { return (x + 255) & ~(size_t)255; }
constexpr size_t W_WIN = 0;
constexpr size_t W_WGATE = W_WIN + (size_t)3328 * 1024 * 2;
constexpr size_t W_WUQ = W_WGATE + (size_t)3072 * 1024 * 2;
constexpr size_t W_WK = W_WUQ + (size_t)768 * 256 * 2;
constexpr size_t W_WV = W_WK + (size_t)512 * 256 * 2;
constexpr size_t W_WGLU = W_WV + (size_t)512 * 256 * 2;
constexpr size_t W_WBR = W_WGLU + (size_t)512 * 512 * 2;
constexpr size_t W_WOUT = W_WBR + (size_t)3 * 1024 * 512 * 2;
constexpr size_t W_WGU = W_WOUT + (size_t)1024 * 1024 * 2;
constexpr size_t W_WD = W_WGU + (size_t)5632 * 1024 * 2;
constexpr size_t W_MB = W_WD + (size_t)1024 * 2816 * 2;
constexpr size_t W_MD = W_MB + (size_t)32 * 256 * 256 * 2;
constexpr size_t W_A16 = W_MD + (size_t)32 * 256 * 384 * 2;
constexpr size_t W_END = W_A16 + (size_t)32 * 64 * 2 * 4;
constexpr size_t O_HRES = al256(W_END);
constexpr size_t O_HBF = O_HRES + (size_t)T * 1024 * 4;
constexpr size_t O_COS = O_HBF + (size_t)T * 1024 * 2;
constexpr size_t O_SIN = O_COS + (size_t)T * 16 * 4;
constexpr size_t O_SSQ = O_SIN + (size_t)T * 16 * 4;
constexpr size_t O_HGDEC = al256(O_SSQ + (size_t)2 * T * 4);
constexpr size_t O_ZHG = al256(O_HGDEC + (size_t)64 * HGC * 128 * 4);
constexpr size_t O_CQKV = O_ZHG + (size_t)T * 2048 * 2;
constexpr size_t O_KA = O_CQKV + (size_t)T * 512 * 2;
constexpr size_t O_VT = O_KA + (size_t)T * 512 * 2 + 65536;
constexpr size_t O_EBUF = O_VT + (size_t)T * 512 * 2 + 65536;
constexpr size_t O_KR = O_EBUF + (size_t)32 * LSEQ * 128 * 4;
constexpr size_t O_BAR = O_KR + (size_t)T * 32 * 2 + 65536;
constexpr size_t O_STATS = O_BAR + 16384;
constexpr size_t O_COLV = O_STATS + (size_t)4 * T * 2 * 4;
constexpr int CV_IN = 0, CV_GATE = 2 * 3328, CV_GU = CV_GATE + 2 * 3072, CV_TOTAL = CV_GU + 2 * 5632;
constexpr size_t O_WSEND = O_COLV + (size_t)CV_TOTAL * 4 + 256;
constexpr size_t O_O = O_CQKV, O_S5OUT = O_KA, O_HGOUT = O_VT, O_YGELU = O_EBUF, O_GATEB = O_ZHG, O_MIXED = O_ZHG + (size_t)T * 1024 * 2, O_HFF = O_ZHG;
constexpr size_t X_UG = 0;
constexpr size_t X_QA = (size_t)32 * SROWS * 384 * 2;
constexpr size_t X_SLOC = X_QA;
static_assert(X_SLOC + (size_t)64 * HGC * 128 * 128 * 2 <= (size_t)NB * 2048 * 1024 * 4, "sloc fits d_out");
static_assert(X_QA + (size_t)(T + 16) * 768 * 2 <= (size_t)NB * 2048 * 1024 * 4, "qa fits d_out");
static_assert(O_WSEND <= (size_t)4 * NB * 2048 * 1024 * 4, "ws fits");
static_assert((size_t)T * 2816 * 2 <= (size_t)T * (2048 + 512 + 512) * 2, "hff fits");
constexpr int VTP = T;

constexpr int LDS_BYTES = 138240 + 16, LDS_BARST = 138240;
constexpr int HG_HALF = 69120, HG_CUM = 0, HG_KRAW = 33280, HG_VT = 50688, CUMP = 130, KRP = 136, VTPP = 72;

struct Params { const void* in[32]; float* out; unsigned char* ws; };
typedef const __attribute__((address_space(4))) Params* KP;
__device__ __forceinline__ KP kp_launder(KP q) { asm volatile("" : "+s"(q)); return q; }
__device__ __forceinline__ KP kparams() { return kp_launder((KP)__builtin_amdgcn_kernarg_segment_ptr()); }

DI int otid() { int t = threadIdx.x; asm volatile("" : "+v"(t)); return t; }
DI int obid() { int b = blockIdx.x; asm volatile("" : "+s"(b)); return b; }
DI int ogrid() { int g = gridDim.x; asm volatile("" : "+s"(g)); return g; }
DI unsigned pk2(float lo, float hi) { f32x2 v = {lo, hi}; bfv2 b = __builtin_convertvector(v, bfv2); return __builtin_bit_cast(unsigned, b); }
DI bf16_t f2bf(float x) { return (bf16_t)(pk2(x, 0.f) & 0xffffu); }
DI float bf2f(bf16_t b) { return __uint_as_float((unsigned)b << 16); }
DI float bflo(unsigned w) { return __uint_as_float(w << 16); }
DI float bfhi(unsigned w) { return __uint_as_float(w & 0xffff0000u); }
DI float sigm(float x) { return 1.f / (1.f + __expf(-x)); }
DI float gelu_tanh(float x) { const float u = 0.7978845608028654f * (x + 0.044715f * x * x * x); const float t = 1.f - 2.f / (1.f + __expf(2.f * u)); return 0.5f * x * (1.f + t); }
DI u32x4 pack8(const f32x4 a, const f32x4 b) { u32x4 w; w.x = pk2(a[0], a[1]); w.y = pk2(a[2], a[3]); w.z = pk2(b[0], b[1]); w.w = pk2(b[2], b[3]); return w; }

DI void ln_stats(const float* st, int r, float& mu, float& rs) { const f32x2 v = *(const f32x2*)(st + (size_t)r * 2); mu = v.x * (1.f / 1024.f); rs = rsqrtf(fmaxf(v.y * (1.f / 1024.f) - mu * mu, 0.f) + 1e-5f); }
DI void ln_fix(f32x4& v0, f32x4& v1, float mu, float rs, const float* cs, const float* bw, int col) {
    const f32x4 c0 = *(const f32x4*)(cs + col), c1 = *(const f32x4*)(cs + col + 4), b0 = *(const f32x4*)(bw + col), b1 = *(const f32x4*)(bw + col + 4);
    v0 = (v0 - c0 * mu) * rs + b0; v1 = (v1 - c1 * mu) * rs + b1; }

struct CV4 { f32x4 c0, c1, b0, b1; };
DI CV4 cv_load(const float* cs, const float* bw, int col) { CV4 v; v.c0 = *(const f32x4*)(cs + col); v.c1 = *(const f32x4*)(cs + col + 4); v.b0 = *(const f32x4*)(bw + col); v.b1 = *(const f32x4*)(bw + col + 4); return v; }
DI void ln_fix2(f32x4& v0, f32x4& v1, float mu, float rs, const CV4& c) { v0 = (v0 - c.c0 * mu) * rs + c.b0; v1 = (v1 - c.c1 * mu) * rs + c.b1; }

namespace pg8 {
constexpr int BM = 256, BK = 64, HALF = 128, HTB = HALF * BK * 2, STAGE_BYTES = 8 * HTB;
DI int lds_byte(int r, int c) { const int st = (r >> 4) * 2 + (c >> 5), rr = r & 15, cc = c & 31, ob = rr * 64 + cc * 2; return st * 1024 + (ob ^ (((ob >> 9) & 1) << 5)); }
DI void stage_rc(int b, int& R, int& C) { const int st = b / 1024, sb = b % 1024, swz = sb ^ (((sb >> 9) & 1) << 5); R = (st >> 1) * 16 + swz / 64; C = (st & 1) * 32 + (swz % 64) / 2; }
DI int perm32(int rho) { const int n = rho >> 4, i = rho & 15; return 8 * (i >> 2) + 4 * n + (i & 3); }

struct GUnit { const char* a; const char* b; int pm, pn, tag; };

template <class Epi, class Sched>
DI void gemm_phase(LAS unsigned char* lds, const Sched& S, const Epi& E) {
    const int tid = otid(), wid = __builtin_amdgcn_readfirstlane(tid >> 6), lane = tid & 63, wr = wid >> 2, wc = wid & 3, fr = lane & 15, fq = lane >> 4;
    int sR[2], sC[2], sRb[2];
#pragma unroll
    for (int i = 0; i < 2; ++i) { int R, C; stage_rc(tid * 16 + i * 8192, R, C); sR[i] = R; sC[i] = C; sRb[i] = (R & ~31) + perm32(R & 31); }
    const size_t kstep = (size_t)(BK * 2);
    const unsigned ldsw = (unsigned)wid * 1024u;
    const int aoff = lds_byte(wr * 64 + fr, fq * 8), boff = lds_byte(wc * 32 + fr, fq * 8);
#define PG8_SA(b, h) (((b) * 2 + (h)) * HTB)
#define PG8_SB(b, h) ((4 + (b) * 2 + (h)) * HTB)
#define PG8_STAGE(bufoff, gbase, v0, v1) do { \
        __builtin_amdgcn_global_load_lds((const unsigned*)((const char*)(gbase) + (v0)), (LAS unsigned*)(lds + (bufoff) + ldsw), 16, 0, 0); \
        __builtin_amdgcn_global_load_lds((const unsigned*)((const char*)(gbase) + (v1)), (LAS unsigned*)(lds + (bufoff) + ldsw + 8192), 16, 0, 0); } while (0)
#define PG8_LDA(dst, b, h) do { _Pragma("unroll") for (int m = 0; m < 4; ++m) _Pragma("unroll") for (int k = 0; k < 2; ++k) dst[m][k] = *(const LAS bf16x8*)(lds + PG8_SA(b, h) + aoff + m * 2048 + k * 1024); } while (0)
#define PG8_LDB(dst, b, h) do { _Pragma("unroll") for (int n = 0; n < 2; ++n) _Pragma("unroll") for (int k = 0; k < 2; ++k) dst[n][k] = *(const LAS bf16x8*)(lds + PG8_SB(b, h) + boff + n * 2048 + k * 1024); } while (0)
#define PG8_MMA(ai, bj, At, Bt) do { __builtin_amdgcn_s_setprio(1); _Pragma("unroll") for (int m = 0; m < 4; ++m) _Pragma("unroll") for (int n = 0; n < 2; ++n) _Pragma("unroll") for (int k = 0; k < 2; ++k) \
        acc[ai][bj][m][n] = __builtin_amdgcn_mfma_f32_16x16x32_bf16(Bt[n][k], At[m][k], acc[ai][bj][m][n], 0, 0, 0); __builtin_amdgcn_s_setprio(0); } while (0)
#define PG8_WAIT_V(n) asm volatile("s_waitcnt vmcnt(" #n ")" ::: "memory")
#define PG8_WAIT_L(n) asm volatile("s_waitcnt lgkmcnt(" #n ")" ::: "memory")
#define PG8_BAR __builtin_amdgcn_s_barrier()
#define PG8_SCHED __builtin_amdgcn_sched_barrier(0)
    GUnit cur, nxt; int ui = 0;
    if (!S.next(0, cur)) return;
    f32x4 acc[2][2][4][2];
#pragma unroll
    for (int a = 0; a < 2; ++a)
#pragma unroll
        for (int b = 0; b < 2; ++b)
#pragma unroll
            for (int m = 0; m < 4; ++m)
#pragma unroll
                for (int n = 0; n < 2; ++n) acc[a][b][m][n] = (f32x4){0.f, 0.f, 0.f, 0.f};
    bf16x8 At[4][2], B0[2][2], B1[2][2];
    const char* cA = cur.a; const char* cB = cur.b;
    const int lda = S.lda, ldb = S.ldb, nt = S.nt;
    const unsigned vA0 = (unsigned)(sR[0] * lda + sC[0]) * 2u, vA1 = (unsigned)(sR[1] * lda + sC[1]) * 2u;
    const unsigned vB0 = (unsigned)(sRb[0] * ldb + sC[0]) * 2u, vB1 = (unsigned)(sRb[1] * ldb + sC[1]) * 2u;
    const size_t hA = (size_t)HALF * lda * 2, hB = (size_t)HALF * ldb * 2;
    PG8_STAGE(PG8_SB(0, 0), cB, vB0, vB1); PG8_STAGE(PG8_SB(0, 1), cB + hB, vB0, vB1); PG8_STAGE(PG8_SA(0, 0), cA, vA0, vA1); PG8_STAGE(PG8_SA(0, 1), cA + hA, vA0, vA1);
    if (wr == 1) PG8_BAR;
    PG8_WAIT_V(2); PG8_BAR;
    PG8_STAGE(PG8_SB(1, 0), cB + kstep, vB0, vB1); PG8_STAGE(PG8_SA(1, 0), cA + kstep, vA0, vA1); PG8_STAGE(PG8_SB(1, 1), cB + hB + kstep, vB0, vB1);
    PG8_WAIT_V(6); PG8_BAR;
    for (;;) {
        const bool has_next = S.next(ui + 1, nxt);
        const char* nA = has_next ? nxt.a : cA; const char* nB = has_next ? nxt.b : cB;
        for (int t = 0; t < nt; t += 2) {
            const bool last = (t == nt - 2);
            const char* a1 = cA + (size_t)(t + 1) * kstep;
            const char* a2 = last ? nA : cA + (size_t)(t + 2) * kstep; const char* b2 = last ? nB : cB + (size_t)(t + 2) * kstep;
            const char* a3 = a2 + kstep; const char* b3 = b2 + kstep;
            PG8_LDB(B0, 0, 0); PG8_LDB(B1, 0, 1); PG8_SCHED; PG8_LDA(At, 0, 0); PG8_STAGE(PG8_SA(1, 1), a1 + hA, vA0, vA1);
            PG8_WAIT_V(8); PG8_WAIT_L(0); PG8_BAR; PG8_MMA(0, 0, At, B0); PG8_MMA(0, 1, At, B1); PG8_BAR; PG8_SCHED;
            PG8_LDA(At, 0, 1); PG8_STAGE(PG8_SB(0, 0), b2, vB0, vB1); PG8_STAGE(PG8_SB(0, 1), b2 + hB, vB0, vB1); PG8_STAGE(PG8_SA(0, 0), a2, vA0, vA1);
            PG8_WAIT_V(8); PG8_WAIT_L(0); PG8_BAR; PG8_MMA(1, 0, At, B0); PG8_MMA(1, 1, At, B1); PG8_BAR; PG8_SCHED;
            PG8_LDB(B0, 1, 0); PG8_LDB(B1, 1, 1); PG8_SCHED; PG8_LDA(At, 1, 0); PG8_STAGE(PG8_SA(0, 1), a2 + hA, vA0, vA1);
            PG8_WAIT_V(8); PG8_WAIT_L(0); PG8_BAR; PG8_MMA(0, 0, At, B0); PG8_MMA(0, 1, At, B1); PG8_BAR; PG8_SCHED;
            PG8_LDA(At, 1, 1); PG8_STAGE(PG8_SB(1, 0), b3, vB0, vB1); PG8_STAGE(PG8_SB(1, 1), b3 + hB, vB0, vB1); PG8_STAGE(PG8_SA(1, 0), a3, vA0, vA1);
            PG8_WAIT_V(8); PG8_WAIT_L(0); PG8_BAR; PG8_MMA(1, 0, At, B0); PG8_MMA(1, 1, At, B1); PG8_BAR; PG8_SCHED;
        }
        if (wr == 0) PG8_BAR;
        E(acc, cur, wr, wc, fr, fq);
        if (!has_next) break;
#pragma unroll
        for (int a = 0; a < 2; ++a)
#pragma unroll
            for (int b = 0; b < 2; ++b)
#pragma unroll
                for (int m = 0; m < 4; ++m)
#pragma unroll
                    for (int n = 0; n < 2; ++n) acc[a][b][m][n] = (f32x4){0.f, 0.f, 0.f, 0.f};
        cur = nxt; cA = nA; cB = nB; ++ui;
        if (wr == 1) PG8_BAR;
    }
    PG8_WAIT_V(0);
    PG8_BAR;
#undef PG8_SA
#undef PG8_SB
#undef PG8_STAGE
#undef PG8_LDA
#undef PG8_LDB
#undef PG8_MMA
#undef PG8_WAIT_V
#undef PG8_WAIT_L
#undef PG8_BAR
#undef PG8_SCHED
}

struct SchedGrid {
    const char* A; const char* B; int lda, ldb, nt, nM, nN, G, c;
    DI bool next(int i, GUnit& u) const {
        const int nwg = nM * nN; const long L = (long)i * G + c; if (L >= nwg) return false;
        int wgid = (int)L; { const int q = nwg / 8, r = nwg % 8, xcd = wgid % 8, off = wgid / 8; wgid = (xcd < r ? xcd * (q + 1) : r * (q + 1) + (xcd - r) * q) + off; }
        const int nig = 8 * nN, gid = wgid / nig, fm = gid * 8, gsz = (nM - fm) < 8 ? (nM - fm) : 8;
        u.pm = fm + ((wgid % nig) % gsz); u.pn = (wgid % nig) / gsz;
        u.a = A + (size_t)u.pm * 256 * lda * 2; u.b = B + (size_t)u.pn * 256 * ldb * 2; u.tag = 0; return true;
    }
};
}
using pg8::GUnit;

#define EPI_ROWS(ai, m) (u.pm * 256 + (ai) * 128 + wr * 64 + (m) * 16 + fr)
#define EPI_COL(bj) (u.pn * 256 + (bj) * 128 + wc * 32 + 8 * fq)

struct EpiA {
    bf16_t* ug; bf16_t* zhg; bf16_t* cqkv; bf16_t* kr; float* ssq; const float* cosT; const float* sinT; const float* st; const float* cs; const float* bw;
    DI void operator()(const f32x4 (&acc_)[2][2][4][2], const GUnit& u, int wr, int wc, int fr, int fq) const {
        const int pn = u.pn;
        CV4 cv0, cv1; if (st) { cv0 = cv_load(cs, bw, EPI_COL(0)); cv1 = cv_load(cs, bw, EPI_COL(1)); }
#pragma unroll
        for (int ai = 0; ai < 2; ++ai)
#pragma unroll
            for (int m = 0; m < 4; ++m) {
                const int r = EPI_ROWS(ai, m);
                f32x4 acc[2][2][4][2];
                acc[ai][0][m][0] = acc_[ai][0][m][0]; acc[ai][0][m][1] = acc_[ai][0][m][1]; acc[ai][1][m][0] = acc_[ai][1][m][0]; acc[ai][1][m][1] = acc_[ai][1][m][1];
                if (st) { float mu, rs; ln_stats(st, r, mu, rs);
                    ln_fix2(acc[ai][0][m][0], acc[ai][0][m][1], mu, rs, cv0); ln_fix2(acc[ai][1][m][0], acc[ai][1][m][1], mu, rs, cv1); }
                if (pn < 2) {
                    const int b = r / LSEQ, tt = r - b * LSEQ, chunk = tt >> 4, s = tt & 15;
#pragma unroll
                    for (int bj = 0; bj < 2; ++bj) { const int col = EPI_COL(bj); const int g = col >> 4, c = col & 15;
                        *(u32x4*)(ug + ((size_t)(g * SROWS + b * NCHK + chunk) * 384 + s * 16 + c)) = pack8(acc[ai][bj][m][0], acc[ai][bj][m][1]); }
                } else if (pn < 10) {
#pragma unroll
                    for (int bj = 0; bj < 2; ++bj) { const int col = EPI_COL(bj) - 512;
                        *(u32x4*)(zhg + ((size_t)r * 2048 + col)) = pack8(acc[ai][bj][m][0], acc[ai][bj][m][1]); }
                } else if (pn < 12) {
                    float sq = 0.f;
#pragma unroll
                    for (int bj = 0; bj < 2; ++bj) { const int col = EPI_COL(bj) - 2560;
                        const f32x4 v0 = acc[ai][bj][m][0], v1 = acc[ai][bj][m][1];
                        sq += v0[0] * v0[0] + v0[1] * v0[1] + v0[2] * v0[2] + v0[3] * v0[3] + v1[0] * v1[0] + v1[1] * v1[1] + v1[2] * v1[2] + v1[3] * v1[3];
                        *(u32x4*)(cqkv + ((size_t)r * 512 + col)) = pack8(v0, v1); }
                    sq += __shfl_xor(sq, 16); sq += __shfl_xor(sq, 32);
                    if (fq == 0) atomicAdd(ssq + (size_t)(pn - 10) * T + r, sq);
                } else {
                    f32x4 v0 = acc[ai][0][m][0], v1 = acc[ai][0][m][1];
                    f32x4 o0, o1;
#pragma unroll
                    for (int e = 0; e < 4; ++e) { o0[e] = __shfl_xor(v0[e], 32); o1[e] = __shfl_xor(v1[e], 32); }
                    if (wc == 0) {
                        const int ib = 8 * (fq & 1);
                        const f32x4 c0 = *(const f32x4*)(cosT + (size_t)r * 16 + ib), c1 = *(const f32x4*)(cosT + (size_t)r * 16 + ib + 4);
                        const f32x4 s0 = *(const f32x4*)(sinT + (size_t)r * 16 + ib), s1 = *(const f32x4*)(sinT + (size_t)r * 16 + ib + 4);
                        f32x4 r0, r1;
                        if (fq < 2) { r0 = v0 * c0 - o0 * s0; r1 = v1 * c1 - o1 * s1; } else { r0 = o0 * s0 + v0 * c0; r1 = o1 * s1 + v1 * c1; }
                        *(u32x4*)(kr + ((size_t)r * 32 + 8 * fq)) = pack8(r0, r1);
                    }
                }
            }
    }
};

struct EpiB {
    bf16_t* qa; bf16_t* ka; bf16_t* vt; float* ebuf; const float* ssq; const float* cosT; const float* sinT;
    DI void operator()(const f32x4 (&acc)[2][2][4][2], const GUnit& u, int wr, int wc, int fr, int fq) const {
        if (u.tag == 0) {
#pragma unroll
            for (int ai = 0; ai < 2; ++ai)
#pragma unroll
                for (int m = 0; m < 4; ++m) {
                    const int r = EPI_ROWS(ai, m);
                    const float rs = rsqrtf(ssq[r] * (1.f / 256.f) + 1e-6f);
#pragma unroll
                    for (int bj = 0; bj < 2; ++bj) {
                        const int g32 = u.pn * 8 + bj * 4 + wc;
                        f32x4 v0 = acc[ai][bj][m][0] * rs, v1 = acc[ai][bj][m][1] * rs;
                        f32x4 o0, o1;
#pragma unroll
                        for (int e = 0; e < 4; ++e) { o0[e] = __shfl_xor(v0[e], 32); o1[e] = __shfl_xor(v1[e], 32); }
                        if (g32 % 3 == 2) {
                            const int ib = 8 * (fq & 1);
                            const f32x4 c0 = *(const f32x4*)(cosT + (size_t)r * 16 + ib), c1 = *(const f32x4*)(cosT + (size_t)r * 16 + ib + 4);
                            const f32x4 s0 = *(const f32x4*)(sinT + (size_t)r * 16 + ib), s1 = *(const f32x4*)(sinT + (size_t)r * 16 + ib + 4);
                            if (fq < 2) { v0 = v0 * c0 - o0 * s0; v1 = v1 * c1 - o1 * s1; } else { v0 = o0 * s0 + v0 * c0; v1 = o1 * s1 + v1 * c1; }
                        }
                        *(u32x4*)(qa + ((size_t)r * 768 + EPI_COL(bj))) = pack8(v0, v1);
                    }
                }
        } else if (u.tag == 1) {
#pragma unroll
            for (int ai = 0; ai < 2; ++ai)
#pragma unroll
                for (int m = 0; m < 4; ++m) {
                    const int r = EPI_ROWS(ai, m);
                    const float rs = rsqrtf(ssq[T + r] * (1.f / 256.f) + 1e-6f);
#pragma unroll
                    for (int bj = 0; bj < 2; ++bj) *(u32x4*)(ka + ((size_t)r * 512 + EPI_COL(bj))) = pack8(acc[ai][bj][m][0] * rs, acc[ai][bj][m][1] * rs);
                }
        } else if (u.tag == 2) {
#pragma unroll
            for (int bj = 0; bj < 2; ++bj) {
                const int col = EPI_COL(bj);
                f32x4 rs0, rs1;
#pragma unroll
                for (int e = 0; e < 4; ++e) { rs0[e] = rsqrtf(ssq[T + col + e] * (1.f / 256.f) + 1e-6f); rs1[e] = rsqrtf(ssq[T + col + 4 + e] * (1.f / 256.f) + 1e-6f); }
#pragma unroll
                for (int ai = 0; ai < 2; ++ai)
#pragma unroll
                    for (int m = 0; m < 4; ++m) { const int r = EPI_ROWS(ai, m);
                        *(u32x4*)(vt + ((size_t)r * VTP + col)) = pack8(acc[ai][bj][m][0] * rs0, acc[ai][bj][m][1] * rs1); }
            }
        } else {
            const int g = u.pm / 9, rt = u.pm - g * 9;
#pragma unroll
            for (int ai = 0; ai < 2; ++ai)
#pragma unroll
                for (int m = 0; m < 4; ++m) {
                    const int R = rt * 256 + ai * 128 + wr * 64 + m * 16 + fr;
                    if (R < LSEQ) { float* p = ebuf + ((size_t)(g * LSEQ + R) * 128 + wc * 32 + 8 * fq);
                        *(f32x4*)p = acc[ai][0][m][0]; *(f32x4*)(p + 4) = acc[ai][0][m][1]; }
                }
        }
    }
};
struct SchedB {
    const char* A; const char* B; int lda, ldb, nt, tag, G, c;
    DI bool next(int i, GUnit& u) const {
        const int L = i * G + c; u.tag = tag;
        if (tag == 0) { if (L >= 387) return false; u.pm = L / 3; u.pn = L % 3; u.a = A + (size_t)u.pm * 256 * 512 * 2; u.b = B + (size_t)u.pn * 256 * 256 * 2; return true; }
        if (L >= 258) return false;
        if (tag == 1) { u.pm = L / 2; u.pn = L % 2; u.a = A + (size_t)u.pm * 256 * 512 * 2; u.b = B + (size_t)u.pn * 256 * 256 * 2; return true; }
        u.pm = L % 2; u.pn = L / 2; u.a = A + (size_t)u.pm * 256 * 256 * 2; u.b = B + (size_t)u.pn * 256 * 512 * 2; return true;
    }
};

struct EpiS5Y {
    bf16_t* yg;
    DI void operator()(const f32x4 (&acc)[2][2][4][2], const GUnit& u, int wr, int wc, int fr, int fq) const {
        const int g = u.pm / 9, rt = u.pm - g * 9;
#pragma unroll
        for (int ai = 0; ai < 2; ++ai)
#pragma unroll
            for (int m = 0; m < 4; ++m) {
                const int R = rt * 256 + ai * 128 + wr * 64 + m * 16 + fr;
                if (R < LSEQ) {
                    const int b = R / NCHK, chunk = R - b * NCHK;
#pragma unroll
                    for (int bj = 0; bj < 2; ++bj) {
                        const int col = bj * 128 + wc * 32 + 8 * fq, t = col >> 4, co = col & 15;
                        f32x4 v0 = acc[ai][bj][m][0], v1 = acc[ai][bj][m][1];
#pragma unroll
                        for (int e = 0; e < 4; ++e) { v0[e] = gelu_tanh(v0[e]); v1[e] = gelu_tanh(v1[e]); }
                        *(u32x4*)(yg + ((size_t)(b * LSEQ + chunk * 16 + t) * 512 + g * 16 + co)) = pack8(v0, v1);
                    }
                }
            }
    }
};
struct SchedS5 {
    const char* ug; const char* mat; int lda, ldb, nt, tag, G, c;
    DI bool next(int i, GUnit& u) const {
        const int L = i * G + c; if (L >= 288) return false;
        const int g = L / 9, rt = L - g * 9; u.tag = tag; u.pm = L; u.pn = 0;
        u.a = ug + ((size_t)g * SROWS + rt * 256) * 384 * 2; u.b = mat + (size_t)g * 256 * ldb * 2; return true;
    }
};

struct EpiGlu {
    const bf16_t* yg; bf16_t* out;
    DI void operator()(const f32x4 (&acc)[2][2][4][2], const GUnit& u, int wr, int wc, int fr, int fq) const {
#pragma unroll
        for (int ai = 0; ai < 2; ++ai)
#pragma unroll
            for (int m = 0; m < 4; ++m) { const int r = EPI_ROWS(ai, m);
#pragma unroll
                for (int bj = 0; bj < 2; ++bj) { const size_t off = (size_t)r * 512 + EPI_COL(bj);
                    const u32x4 y = *(const u32x4*)(yg + off); const f32x4 a0 = acc[ai][bj][m][0], a1 = acc[ai][bj][m][1];
                    f32x4 v0, v1;
                    v0[0] = bflo(y.x) * sigm(a0[0]); v0[1] = bfhi(y.x) * sigm(a0[1]); v0[2] = bflo(y.y) * sigm(a0[2]); v0[3] = bfhi(y.y) * sigm(a0[3]);
                    v1[0] = bflo(y.z) * sigm(a1[0]); v1[1] = bfhi(y.z) * sigm(a1[1]); v1[2] = bflo(y.w) * sigm(a1[2]); v1[3] = bfhi(y.w) * sigm(a1[3]);
                    *(u32x4*)(out + off) = pack8(v0, v1); } }
    }
};

struct EpiF {
    bf16_t* gateb; bf16_t* mixed; const float* st; const float* cs; const float* bw; unsigned* flags; unsigned base;
    DI void operator()(const f32x4 (&acc)[2][2][4][2], const GUnit& u, int wr, int wc, int fr, int fq) const {
        const int j = u.tag & 7; const bool tail = (u.tag & 8) != 0;
        if (tail && j > 0) {
            unsigned* f = flags + 64 * u.pn; const unsigned need = base + 8u * (unsigned)j; unsigned sp = 0;
            while (__hip_atomic_load(f, __ATOMIC_RELAXED, __HIP_MEMORY_SCOPE_AGENT) < need && ++sp < (1u << 22)) __builtin_amdgcn_s_sleep(1);
            __builtin_amdgcn_fence(__ATOMIC_ACQUIRE, "agent");
        }
        CV4 cvv[2]; if (st && (j & 1) == 0) { cvv[0] = cv_load(cs, bw, (j >> 1) * 1024 + EPI_COL(0)); cvv[1] = cv_load(cs, bw, (j >> 1) * 1024 + EPI_COL(1)); }
#pragma unroll
        for (int ai = 0; ai < 2; ++ai)
#pragma unroll
            for (int m = 0; m < 4; ++m) { const int r = EPI_ROWS(ai, m);
                float mu = 0.f, rs = 1.f; if (st && (j & 1) == 0) ln_stats(st, r, mu, rs);
#pragma unroll
                for (int bj = 0; bj < 2; ++bj) { const size_t off = (size_t)r * 1024 + EPI_COL(bj);
                    f32x4 a0 = acc[ai][bj][m][0], a1 = acc[ai][bj][m][1];
                    if ((j & 1) == 0) {
                        if (st) ln_fix2(a0, a1, mu, rs, cvv[bj]);
#pragma unroll
                        for (int e = 0; e < 4; ++e) { a0[e] = sigm(a0[e]); a1[e] = sigm(a1[e]); }
                        *(u32x4*)(gateb + off) = pack8(a0, a1);
                    } else {
                        const u32x4 gt = *(const u32x4*)(gateb + off);
                        a0[0] *= bflo(gt.x); a0[1] *= bfhi(gt.x); a0[2] *= bflo(gt.y); a0[3] *= bfhi(gt.y);
                        a1[0] *= bflo(gt.z); a1[1] *= bfhi(gt.z); a1[2] *= bflo(gt.w); a1[3] *= bfhi(gt.w);
                        if (j > 1) { const u32x4 mx = *(const u32x4*)(mixed + off);
                            a0[0] += bflo(mx.x); a0[1] += bfhi(mx.x); a0[2] += bflo(mx.y); a0[3] += bfhi(mx.y);
                            a1[0] += bflo(mx.z); a1[1] += bfhi(mx.z); a1[2] += bflo(mx.w); a1[3] += bfhi(mx.w); }
                        *(u32x4*)(mixed + off) = pack8(a0, a1);
                    } } }
        if (tail) { asm volatile("s_waitcnt vmcnt(0)" ::: "memory"); __builtin_amdgcn_fence(__ATOMIC_RELEASE, "agent"); asm volatile("s_waitcnt vmcnt(0)" ::: "memory");
            if ((otid() & 63) == 0) __hip_atomic_fetch_add(flags + 64 * u.pn, 1u, __ATOMIC_RELAXED, __HIP_MEMORY_SCOPE_AGENT); }
    }
};
struct SchedF {
    const char* A; const char* B; int lda, ldb, nt, j, G, c;
    DI bool next(int i, GUnit& u) const {
        int tI = i * G + c; u.tag = j;
        if (tI >= 512) { const int t = c - 4 * j; if (i * G >= 512 + G || t < 0 || t >= 4 || (i > 0 && (i - 1) * G + c >= 512)) return false; tI = 512 + t; u.tag = j | 8; }
        u.pm = tI >> 2; u.pn = tI & 3;
        u.a = A + (size_t)u.pm * 256 * lda * 2; u.b = B + (size_t)u.pn * 256 * ldb * 2; return true;
    }
};

struct EpiRes {
    float* hres; bf16_t* hbf; const float* st_in; const float* g_in; const float* b_in; float* st_out;
    DI void operator()(const f32x4 (&acc)[2][2][4][2], const GUnit& u, int wr, int wc, int fr, int fq) const {
        CV4 gb[2]; if (st_in) { gb[0] = cv_load(g_in, b_in, EPI_COL(0)); gb[1] = cv_load(g_in, b_in, EPI_COL(1)); }
#pragma unroll
        for (int ai = 0; ai < 2; ++ai)
#pragma unroll
            for (int m = 0; m < 4; ++m) { const int r = EPI_ROWS(ai, m);
                float mu = 0.f, rs = 1.f; if (st_in) ln_stats(st_in, r, mu, rs);
                float a1 = 0.f, a2 = 0.f;
#pragma unroll
                for (int bj = 0; bj < 2; ++bj) { const int col = EPI_COL(bj); float* p = hres + (size_t)r * 1024 + col;
                    f32x4 h0 = *(const f32x4*)p, h1 = *(const f32x4*)(p + 4);
                    if (st_in) { h0 = (h0 - mu) * rs * gb[bj].c0 + gb[bj].b0; h1 = (h1 - mu) * rs * gb[bj].c1 + gb[bj].b1; }
                    const f32x4 r0 = h0 * ALPHA + acc[ai][bj][m][0], r1 = h1 * ALPHA + acc[ai][bj][m][1];
                    *(f32x4*)p = r0; *(f32x4*)(p + 4) = r1;
                    *(u32x4*)(hbf + (size_t)r * 1024 + col) = pack8(r0, r1);
                    a1 += (r0[0] + r0[1]) + (r0[2] + r0[3]) + (r1[0] + r1[1]) + (r1[2] + r1[3]);
                    a2 += (r0[0] * r0[0] + r0[1] * r0[1]) + (r0[2] * r0[2] + r0[3] * r0[3]) + (r1[0] * r1[0] + r1[1] * r1[1]) + (r1[2] * r1[2] + r1[3] * r1[3]); }
                a1 += __shfl_xor(a1, 16); a1 += __shfl_xor(a1, 32); a2 += __shfl_xor(a2, 16); a2 += __shfl_xor(a2, 32);
                if (fq == 0) { atomicAdd(st_out + (size_t)r * 2, a1); atomicAdd(st_out + (size_t)r * 2 + 1, a2); } }
    }
};
struct EpiFfn1 {
    bf16_t* hff; const float* st; const float* cs; const float* bw;
    DI void operator()(const f32x4 (&acc)[2][2][4][2], const GUnit& u, int wr, int wc, int fr, int fq) const {
        const CV4 cvg = cv_load(cs, bw, EPI_COL(0)), cvu = cv_load(cs, bw, EPI_COL(1));
#pragma unroll
        for (int ai = 0; ai < 2; ++ai)
#pragma unroll
            for (int m = 0; m < 4; ++m) { const int r = EPI_ROWS(ai, m);
                f32x4 v0, v1; f32x4 g0 = acc[ai][0][m][0], g1 = acc[ai][0][m][1], u0 = acc[ai][1][m][0], u1 = acc[ai][1][m][1];
                { float mu, rs; ln_stats(st, r, mu, rs); ln_fix2(g0, g1, mu, rs, cvg); ln_fix2(u0, u1, mu, rs, cvu); }
#pragma unroll
                for (int e = 0; e < 4; ++e) { v0[e] = g0[e] * sigm(g0[e]) * u0[e]; v1[e] = g1[e] * sigm(g1[e]) * u1[e]; }
                *(u32x4*)(hff + ((size_t)r * DFF + u.pn * 128 + wc * 32 + 8 * fq)) = pack8(v0, v1); }
    }
};

template <class F> DI void tconv(bf16_t* dst, int N, int K, int gtid_, int gthreads, F f) {
    const int gtid = blockIdx.x * 512 + otid(); gthreads = ogrid() * 512;
    const int kb8 = K / 8; const long total = (long)N * kb8;
    for (long idx = gtid; idx < total; idx += gthreads) {
        const int n = (int)(idx % N), kb = (int)(idx / N);
        float v[8];
#pragma unroll
        for (int i = 0; i < 8; ++i) v[i] = f(n, kb * 8 + i);
        u32x4 w; w.x = pk2(v[0], v[1]); w.y = pk2(v[2], v[3]); w.z = pk2(v[4], v[5]); w.w = pk2(v[6], v[7]);
        *(u32x4*)(dst + ((size_t)n * K + kb * 8)) = w;
    }
}

template <class F> DI void colvec(float* cs, float* bw, int N, int K, const float* g, const float* b, LAS unsigned char* lds, F f) {
    LAS float* red = (LAS float*)lds;
    const int tid = otid(), nn = tid & 31, ks = tid >> 5, G = ogrid(), kper = K >> 4;
    for (int task = blockIdx.x; task * 32 < N; task += G) {
        const int n = task * 32 + nn; float a = 0.f, c = 0.f;
#pragma unroll 8
        for (int kk = 0; kk < kper; ++kk) { const int k = ks * kper + kk; const float w = f(n, k); a += bflo(pk2(w * g[k], 0.f)); c += b[k] * w; }
        __syncthreads();
        red[(ks * 32 + nn) * 2] = a; red[(ks * 32 + nn) * 2 + 1] = c;
        __syncthreads();
        if (tid < 32) { float sa = 0.f, sc = 0.f;
#pragma unroll
            for (int j = 0; j < 16; ++j) { sa += red[(j * 32 + tid) * 2]; sc += red[(j * 32 + tid) * 2 + 1]; }
            cs[task * 32 + tid] = sa; bw[task * 32 + tid] = sc; }
    }
    __syncthreads();
}
DI void convert_weights(KP p, int l, int part, LAS unsigned char* lds) {
    const int gtid = 0, gthreads = 0;
    p = kp_launder(p);
    unsigned char* ws = p->ws; float* cv = (float*)(ws + O_COLV);
    if (part == 0) {
    { const float* w = (const float*)p->in[5] + (size_t)l * 1024 * 6176; const float* g2 = (const float*)p->in[30] + (l - 1) * 1024; const float* b2 = (const float*)p->in[31] + (l - 1) * 1024; const bool fold = l > 0;
      auto fin = [=](int n, int k) -> float { const int src = n < 512 ? 544 + n : (n < 2560 ? 1056 + (n - 512) : (n < 3104 ? n - 2560 : -1)); return src < 0 ? 0.f : w[(size_t)k * 6176 + src]; };
      auto fgate = [=](int n, int k) -> float { return w[(size_t)k * 6176 + 3104 + n]; };
      tconv((bf16_t*)(ws + W_WIN), 3328, 1024, gtid, gthreads, [=](int n, int k) -> float { const float v = fin(n, k); return fold ? v * g2[k] : v; });
      tconv((bf16_t*)(ws + W_WGATE), 3072, 1024, gtid, gthreads, [=](int n, int k) -> float { const float v = fgate(n, k); return fold ? v * g2[k] : v; });
      if (fold) { colvec(cv + CV_IN, cv + CV_IN + 3328, 3328, 1024, g2, b2, lds, fin); colvec(cv + CV_GATE, cv + CV_GATE + 3072, 3072, 1024, g2, b2, lds, fgate); } }
    { const float* w = (const float*)p->in[7] + (size_t)l * 256 * 768; const float* g = (const float*)p->in[6] + l * 256;
      tconv((bf16_t*)(ws + W_WUQ), 768, 256, gtid, gthreads, [=](int n, int k) -> float { return w[(size_t)k * 768 + n] * g[k] * QSCALE; }); }
    { const float* w = (const float*)p->in[9] + (size_t)l * 256 * 1024; const float* g = (const float*)p->in[8] + l * 256;
      tconv((bf16_t*)(ws + W_WK), 512, 256, gtid, gthreads, [=](int n, int k) -> float { return w[(size_t)k * 1024 + (n >> 6) * 128 + (n & 63)] * g[k]; });
      tconv((bf16_t*)(ws + W_WV), 512, 256, gtid, gthreads, [=](int n, int k) -> float { return w[(size_t)k * 1024 + (n >> 6) * 128 + 64 + (n & 63)] * g[k]; }); }
    { const float* w = (const float*)p->in[18] + (size_t)l * 512 * 512;
      tconv((bf16_t*)(ws + W_WGLU), 512, 512, gtid, gthreads, [=](int n, int k) -> float { return w[(size_t)k * 512 + n]; }); }
#pragma unroll
    for (int br = 0; br < 3; ++br) { const float* w = (const float*)p->in[21 + br] + (size_t)l * 512 * 1024;
      tconv((bf16_t*)(ws + W_WBR) + (size_t)br * 1024 * 512, 1024, 512, gtid, gthreads, [=](int n, int k) -> float { return w[(size_t)k * 1024 + n]; }); }
    { const float* w = (const float*)p->in[24] + (size_t)l * 1024 * 1024;
      tconv((bf16_t*)(ws + W_WOUT), 1024, 1024, gtid, gthreads, [=](int n, int k) -> float { return w[(size_t)k * 1024 + n]; }); }
    } else {
    { const float* wg = (const float*)p->in[27] + (size_t)l * 1024 * DFF; const float* wu = (const float*)p->in[28] + (size_t)l * 1024 * DFF; const float* g1 = (const float*)p->in[25] + l * 1024; const float* b1 = (const float*)p->in[26] + l * 1024;
      auto fgu = [=](int n, int k) -> float { const int pn = n >> 8, r = n & 255; return r < 128 ? wg[(size_t)k * DFF + pn * 128 + r] : wu[(size_t)k * DFF + pn * 128 + r - 128]; };
      tconv((bf16_t*)(ws + W_WGU), 5632, 1024, gtid, gthreads, [=](int n, int k) -> float { return fgu(n, k) * g1[k]; });
      colvec(cv + CV_GU, cv + CV_GU + 5632, 5632, 1024, g1, b1, lds, fgu); }
    { const float* w = (const float*)p->in[29] + (size_t)l * DFF * 1024;
      tconv((bf16_t*)(ws + W_WD), 1024, DFF, gtid, gthreads, [=](int n, int k) -> float { return w[(size_t)k * 1024 + n]; }); }
    }
}

DI void s5_build(KP p, int l, LAS unsigned char* lds) {
    p = kp_launder(p);
    LAS float* PT = (LAS float*)lds;
    LAS float* BB = PT + 64 * 17 * 2;
    LAS float* KT = BB + 64 * 16 * 2;
    const int tid = otid(), G = ogrid();
    for (int job = blockIdx.x; job < 256; job += G) {
        const int g = job >> 3, part = job & 7;
        const float* lam_re = (const float*)p->in[10] + (size_t)(l * 32 + g) * 64;
        const float* lam_im = (const float*)p->in[11] + (size_t)(l * 32 + g) * 64;
        const float dt = expf(((const float*)p->in[12])[l * 32 + g]);
        const float* b_re = (const float*)p->in[13] + (size_t)(l * 32 + g) * 64 * 16;
        const float* b_im = (const float*)p->in[14] + (size_t)(l * 32 + g) * 64 * 16;
        const float* c_re = (const float*)p->in[15] + (size_t)(l * 32 + g) * 16 * 64;
        const float* c_im = (const float*)p->in[16] + (size_t)(l * 32 + g) * 16 * 64;
        const float* dsk = (const float*)p->in[17] + (size_t)l * 512 + g * 16;
        __syncthreads();
        for (int idx = tid; idx < 64 * 17; idx += 512) {
            const int n = idx / 17, tau = idx - n * 17;
            const float lr = fminf(lam_re[n], -1e-4f), li = lam_im[n];
            const float mag = expf(lr * dt * (float)tau); float sn, cn; sincosf(li * dt * (float)tau, &sn, &cn);
            PT[idx * 2] = mag * cn; PT[idx * 2 + 1] = mag * sn;
        }
        for (int idx = tid; idx < 64 * 16; idx += 512) {
            const int n = idx >> 4;
            const float lr = fminf(lam_re[n], -1e-4f), li = lam_im[n];
            const float mag = expf(lr * dt); float sn, cn; sincosf(li * dt, &sn, &cn);
            const float abr = mag * cn, abi = mag * sn, den = lr * lr + li * li, nr = abr - 1.f;
            const float cr = (nr * lr + abi * li) / den, ci = (abi * lr - nr * li) / den;
            const float br = b_re[idx], bi = b_im[idx];
            BB[idx * 2] = cr * br - ci * bi; BB[idx * 2 + 1] = cr * bi + ci * br;
        }
        __syncthreads();
        { const int tau = tid >> 5, coi = (tid >> 4) & 1, ci = tid & 15, co = 2 * part + coi;
          float acc = 0.f;
#pragma unroll 8
          for (int n = 0; n < 64; ++n) {
              const float pr = PT[(n * 17 + tau) * 2], pi = PT[(n * 17 + tau) * 2 + 1], br = BB[(n * 16 + ci) * 2], bi = BB[(n * 16 + ci) * 2 + 1];
              const float xr = pr * br - pi * bi, xi = pr * bi + pi * br;
              acc += c_re[co * 64 + n] * xr - c_im[co * 64 + n] * xi;
          }
          KT[tid] = acc; }
        __syncthreads();
        bf16_t* mb = (bf16_t*)(p->ws + W_MB) + (size_t)g * 256 * 256;
        bf16_t* md = (bf16_t*)(p->ws + W_MD) + (size_t)g * 256 * 384;
        for (int idx = tid; idx < 32 * 256; idx += 512) {
            const int col = 32 * part + (idx >> 8), k = idx & 255, sx = k >> 4, cx = k & 15; float v = 0.f;
            if (col < 128) { const int n = col & 63; const float pr = PT[(n * 17 + 15 - sx) * 2], pi = PT[(n * 17 + 15 - sx) * 2 + 1], br = BB[(n * 16 + cx) * 2], bi = BB[(n * 16 + cx) * 2 + 1];
                v = col < 64 ? pr * br - pi * bi : pr * bi + pi * br; }
            mb[(size_t)col * 256 + k] = f2bf(v);
        }
        for (int idx = tid; idx < 32 * 384; idx += 512) {
            const int rr = idx / 384, k = idx - rr * 384, t = rr >> 1, coi = rr & 1, co = 2 * part + coi; float v;
            if (k < 256) { const int sx = k >> 4, ci = k & 15; v = sx <= t ? KT[((t - sx) * 2 + coi) * 16 + ci] : 0.f; if (sx == t && ci == co) v += dsk[co]; }
            else { const int n = (k - 256) & 63; const float pr = PT[(n * 17 + t + 1) * 2], pi = PT[(n * 17 + t + 1) * 2 + 1], cr = c_re[co * 64 + n], ci = c_im[co * 64 + n];
                v = k < 320 ? cr * pr - ci * pi : -(cr * pi + ci * pr); }
            md[(size_t)(t * 16 + co) * 384 + k] = f2bf(v);
        }
        if (part == 0 && tid < 64) { float* a16 = (float*)(p->ws + W_A16) + (size_t)g * 128; a16[tid * 2] = PT[(tid * 17 + 16) * 2]; a16[tid * 2 + 1] = PT[(tid * 17 + 16) * 2 + 1]; }
    }
    __syncthreads();
}

DI void ln_rows(KP p, int mode, const float* gam, const float* bet, int gwave_, int nwaves, int lane_) {
    p = kp_launder(p);
    const int tid_ = otid(), lane = tid_ & 63, gwave = blockIdx.x * 8 + __builtin_amdgcn_readfirstlane(tid_ >> 6); nwaves = ogrid() * 8;
    float* hres = (float*)(p->ws + O_HRES); bf16_t* hbf = (bf16_t*)(p->ws + O_HBF);
    for (int r = gwave; r < T; r += nwaves) {
        const int b = r / LSEQ, tt = r - b * LSEQ;
        const float* src;
        if (mode == 0) src = tt < 16 ? (const float*)p->in[2] + (size_t)tt * 1024 : (const float*)p->in[0] + ((size_t)b * 2048 + tt - 16) * 1024;
        else src = hres + (size_t)r * 1024;
        if (mode == 2 && tt < 16) continue;
        f32x4 v[4]; float s = 0.f;
#pragma unroll
        for (int i = 0; i < 4; ++i) { v[i] = *(const f32x4*)(src + i * 256 + lane * 4); s += v[i][0] + v[i][1] + v[i][2] + v[i][3]; }
#pragma unroll
        for (int o = 1; o < 64; o <<= 1) s += __shfl_xor(s, o);
        const float mu = s * (1.f / 1024.f); float q = 0.f;
#pragma unroll
        for (int i = 0; i < 4; ++i) { const f32x4 d = v[i] - mu; q += d[0] * d[0] + d[1] * d[1] + d[2] * d[2] + d[3] * d[3]; }
#pragma unroll
        for (int o = 1; o < 64; o <<= 1) q += __shfl_xor(q, o);
        const float rstd = rsqrtf(q * (1.f / 1024.f) + 1e-5f);
#pragma unroll
        for (int i = 0; i < 4; ++i) {
            const int c = i * 256 + lane * 4;
            const f32x4 o = (v[i] - mu) * rstd * *(const f32x4*)(gam + c) + *(const f32x4*)(bet + c);
            if (mode == 2) *(f32x4*)(p->out + ((size_t)b * 2048 + tt - 16) * 1024 + c) = o;
            else { *(f32x4*)(hres + (size_t)r * 1024 + c) = o; u32x2 w; w.x = pk2(o[0], o[1]); w.y = pk2(o[2], o[3]); *(u32x2*)(hbf + (size_t)r * 1024 + c) = w; }
        }
    }
}

constexpr int AT_KP = 104, AT_VP = 36, AT_BUF = 32 * AT_KP * 2 + 64 * AT_VP * 2;
DI void attn_softmax_pv(f32x16& S, f32x16& O0, f32x16& O1, float& mrun, float& lsum, const bf16x8 (&vf)[2][2]) {
    float mx = S[0];
#pragma unroll
    for (int r = 1; r < 16; ++r) mx = fmaxf(mx, S[r]);
    mx = fmaxf(mx, __shfl_xor(mx, 32));
    const float mnew = fmaxf(mrun, mx);
    float ps = 0.f;
#pragma unroll
    for (int r = 0; r < 16; ++r) { S[r] = __builtin_amdgcn_exp2f(S[r] - mnew); ps += S[r]; }
    if (__builtin_amdgcn_ballot_w64(mnew > mrun) != 0ull) {
        const float alpha = __builtin_amdgcn_exp2f(mrun - mnew);
        lsum *= alpha;
#pragma unroll
        for (int i = 0; i < 16; ++i) { O0[i] *= alpha; O1[i] *= alpha; }
    }
    mrun = mnew; lsum += ps;
#pragma unroll
    for (int kk = 0; kk < 2; ++kk) {
        u32x4 w; w.x = pk2(S[8 * kk], S[8 * kk + 1]); w.y = pk2(S[8 * kk + 2], S[8 * kk + 3]); w.z = pk2(S[8 * kk + 4], S[8 * kk + 5]); w.w = pk2(S[8 * kk + 6], S[8 * kk + 7]);
        const bf16x8 pf = __builtin_bit_cast(bf16x8, w);
        O0 = __builtin_amdgcn_mfma_f32_32x32x16_bf16(vf[0][kk], pf, O0, 0, 0, 0);
        O1 = __builtin_amdgcn_mfma_f32_32x32x16_bf16(vf[1][kk], pf, O1, 0, 0, 0);
    }
}
DI void attn_store(bf16_t* oo, size_t tokq, int h, int half, const f32x16& O0, const f32x16& O1, float inv) {
#pragma unroll
    for (int blk = 0; blk < 4; ++blk) {
        u32x2 w0, w1;
        w0.x = pk2(O0[4 * blk] * inv, O0[4 * blk + 1] * inv); w0.y = pk2(O0[4 * blk + 2] * inv, O0[4 * blk + 3] * inv);
        w1.x = pk2(O1[4 * blk] * inv, O1[4 * blk + 1] * inv); w1.y = pk2(O1[4 * blk + 2] * inv, O1[4 * blk + 3] * inv);
        *(u32x2*)(oo + tokq * 512 + h * 64 + 8 * blk + 4 * half) = w0;
        *(u32x2*)(oo + tokq * 512 + h * 64 + 32 + 8 * blk + 4 * half) = w1;
    }
}
DI void attention_phase(KP p, LAS unsigned char* lds) {
    p = kp_launder(p);
    const int tid = otid(), lane = tid & 63, wid = __builtin_amdgcn_readfirstlane(tid >> 6);
    const bf16_t* qa = (const bf16_t*)((unsigned char*)p->out + X_QA);
    const bf16_t* ka = (const bf16_t*)(p->ws + O_KA); const bf16_t* kr = (const bf16_t*)(p->ws + O_KR); const bf16_t* vt = (const bf16_t*)(p->ws + O_VT);
    bf16_t* oo = (bf16_t*)(p->ws + O_O);
    const int G = ogrid(), l31 = lane & 31, half = lane >> 5;
    const bool c0k = tid < 384; const int c0 = c0k ? tid : tid - 384, c1 = tid + 128;
    for (int it = 0; it * G < 1024; ++it) {
        const int u = it * G + blockIdx.x;
        if (u >= 1024) break;
        const int bh = u & 127, pp = u >> 7, b = bh >> 3, h = bh & 7;
        const int j = (0x46315720 >> (4 * pp)) & 7;
        const int ktmax = 8 * j + 8, dkt = 8 * j + wid + 1;
        const size_t tok0 = (size_t)b * LSEQ;
        const size_t tokq = tok0 + 16 + 256 * j + 32 * wid + l31;
        bf16x8 qf[6];
#pragma unroll
        for (int ks = 0; ks < 6; ++ks) qf[ks] = *(const bf16x8*)(qa + tokq * 768 + h * 96 + ks * 16 + half * 8);
        f32x16 O0, O1;
#pragma unroll
        for (int i = 0; i < 16; ++i) { O0[i] = 0.f; O1[i] = 0.f; }
        float mrun = -1e30f, lsum = 0.f;
        u32x4 sa[3], sb[3];
#pragma unroll
        for (int i = 0; i < 3; ++i) { sa[i] = (u32x4){0u, 0u, 0u, 0u}; sb[i] = (u32x4){0u, 0u, 0u, 0u}; }
#define AT_GLOAD(kt, slot) do { const int k0_ = (kt) == 0 ? 0 : 16 + 32 * ((kt) - 1); \
            if (c0k) { const int key = c0 / 12, part = c0 - key * 12; const size_t tok = tok0 + k0_ + key; \
                sa[slot] = part < 8 ? *(const u32x4*)(ka + tok * 512 + h * 64 + 8 * part) : *(const u32x4*)(kr + tok * 32 + 8 * (part - 8)); } \
            else { const int dv = c0 >> 2, part = c0 & 3; sa[slot] = *(const u32x4*)(vt + (size_t)(h * 64 + dv) * VTP + tok0 + k0_ + 8 * part); } \
            if (tid < 128) { const int dv = c1 >> 2, part = c1 & 3; sb[slot] = *(const u32x4*)(vt + (size_t)(h * 64 + dv) * VTP + tok0 + k0_ + 8 * part); } } while (0)
#define AT_LSTORE(buf, slot) do { LAS unsigned char* B_ = lds + (buf) * AT_BUF; \
            if (c0k) { const int key = c0 / 12, part = c0 - key * 12; *(LAS u32x4*)(B_ + key * (AT_KP * 2) + part * 16) = sa[slot]; } \
            else { const int dv = c0 >> 2, part = c0 & 3; LAS unsigned char* d = B_ + 32 * AT_KP * 2 + dv * (AT_VP * 2) + part * 16; *(LAS u32x2*)d = (u32x2){sa[slot].x, sa[slot].y}; *(LAS u32x2*)(d + 8) = (u32x2){sa[slot].z, sa[slot].w}; } \
            if (tid < 128) { const int dv = c1 >> 2, part = c1 & 3; LAS unsigned char* d = B_ + 32 * AT_KP * 2 + dv * (AT_VP * 2) + part * 16; *(LAS u32x2*)d = (u32x2){sb[slot].x, sb[slot].y}; *(LAS u32x2*)(d + 8) = (u32x2){sb[slot].z, sb[slot].w}; } } while (0)
#define AT_STEP(kt, slot) do { \
            if ((kt) + 3 <= ktmax) AT_GLOAD((kt) + 3, slot); \
            if ((kt) <= dkt) { \
                const LAS unsigned char* B = lds + ((kt) & 1) * AT_BUF; \
                f32x16 S; \
                _Pragma("unroll") for (int i = 0; i < 16; ++i) S[i] = 0.f; \
                _Pragma("unroll") for (int ks = 0; ks < 6; ++ks) { const bf16x8 kf = *(const LAS bf16x8*)(B + l31 * (AT_KP * 2) + ks * 32 + half * 16); S = __builtin_amdgcn_mfma_f32_32x32x16_bf16(kf, qf[ks], S, 0, 0, 0); } \
                bf16x8 vf[2][2]; \
                _Pragma("unroll") for (int rb = 0; rb < 2; ++rb) _Pragma("unroll") for (int kk = 0; kk < 2; ++kk) { const LAS unsigned char* vp = B + 32 * AT_KP * 2 + (rb * 32 + l31) * (AT_VP * 2) + (kk * 16 + half * 4) * 2; \
                        const u32x2 lo = *(const LAS u32x2*)vp, hi = *(const LAS u32x2*)(vp + 16); u32x4 w; w.x = lo.x; w.y = lo.y; w.z = hi.x; w.w = hi.y; vf[rb][kk] = __builtin_bit_cast(bf16x8, w); } \
                if ((kt) == 0) { _Pragma("unroll") for (int r = 8; r < 16; ++r) S[r] = -1e30f; } \
                if ((kt) == dkt) { _Pragma("unroll") for (int r = 0; r < 16; ++r) { const int kl = 8 * (r >> 2) + 4 * half + (r & 3); if (kl > l31) S[r] = -1e30f; } } \
                attn_softmax_pv(S, O0, O1, mrun, lsum, vf); \
            } \
            if ((kt) < ktmax) AT_LSTORE(((kt) + 1) & 1, ((slot) + 1) % 3); \
            __syncthreads(); } while (0)
        __syncthreads();
        AT_GLOAD(0, 0); AT_GLOAD(1, 1); AT_GLOAD(2, 2);
        AT_LSTORE(0, 0);
        __syncthreads();
        for (int kt = 0; kt <= ktmax; kt += 3) {
            AT_STEP(kt, 0);
            if (kt + 1 <= ktmax) AT_STEP(kt + 1, 1);
            if (kt + 2 <= ktmax) AT_STEP(kt + 2, 2);
        }
#undef AT_GLOAD
#undef AT_LSTORE
#undef AT_STEP
        const float ltot = lsum + __shfl_xor(lsum, 32);
        attn_store(oo, tokq, h, half, O0, O1, 1.f / ltot);
    }
    {
        const int wg = blockIdx.x * 8 + wid;
        if (wg < 128) {
            const int b = wg >> 3, h = wg & 7; const size_t tokq = (size_t)b * LSEQ + l31;
            bf16x8 qf[6], kf[6], vf[2][2];
#pragma unroll
            for (int ks = 0; ks < 6; ++ks) qf[ks] = *(const bf16x8*)(qa + tokq * 768 + h * 96 + ks * 16 + half * 8);
#pragma unroll
            for (int ks = 0; ks < 4; ++ks) kf[ks] = *(const bf16x8*)(ka + tokq * 512 + h * 64 + ks * 16 + half * 8);
#pragma unroll
            for (int ks = 0; ks < 2; ++ks) kf[4 + ks] = *(const bf16x8*)(kr + tokq * 32 + ks * 16 + half * 8);
#pragma unroll
            for (int rb = 0; rb < 2; ++rb)
#pragma unroll
                for (int kk = 0; kk < 2; ++kk) { const bf16_t* vp = vt + (size_t)(h * 64 + rb * 32 + l31) * VTP + (size_t)b * LSEQ + kk * 16 + half * 4;
                    const u32x2 lo = *(const u32x2*)vp, hi = *(const u32x2*)(vp + 8); u32x4 w; w.x = lo.x; w.y = lo.y; w.z = hi.x; w.w = hi.y; vf[rb][kk] = __builtin_bit_cast(bf16x8, w); }
            f32x16 S, O0, O1;
#pragma unroll
            for (int i = 0; i < 16; ++i) { S[i] = 0.f; O0[i] = 0.f; O1[i] = 0.f; }
#pragma unroll
            for (int ks = 0; ks < 6; ++ks) S = __builtin_amdgcn_mfma_f32_32x32x16_bf16(kf[ks], qf[ks], S, 0, 0, 0);
#pragma unroll
            for (int r = 0; r < 16; ++r) { const int kl = 8 * (r >> 2) + 4 * half + (r & 3); if (kl > l31) S[r] = -1e30f; }
            float mrun = -1e30f, lsum = 0.f;
            attn_softmax_pv(S, O0, O1, mrun, lsum, vf);
            const float ltot = lsum + __shfl_xor(lsum, 32);
            if (l31 < 16) attn_store(oo, tokq, h, half, O0, O1, 1.f / ltot);
        }
    }
    __syncthreads();
}

DI void s5_scan(KP p, int gtid_, int gthreads) {
    p = kp_launder(p);
    const int gtid = blockIdx.x * 128 + otid(); gthreads = ogrid() * 128;
    const float* __restrict__ ebuf = (const float*)(p->ws + O_EBUF); const float* a16 = (const float*)(p->ws + W_A16);
    bf16_t* __restrict__ ug = (bf16_t*)((unsigned char*)p->out + X_UG);
    for (int idx = gtid; idx < 32768; idx += gthreads) {
        const int n = idx & 63, b = (idx >> 6) & 15, g = idx >> 10;
        const float ar = a16[(g * 64 + n) * 2], ai = a16[(g * 64 + n) * 2 + 1];
        float xr = 0.f, xi = 0.f;
        const float* e = ebuf + ((size_t)g * LSEQ + b * NCHK) * 128 + n;
        bf16_t* x = ug + ((size_t)g * SROWS + b * NCHK) * 384 + 256 + n;
        float er[8], ei[8], fr_[8], fi_[8];
#pragma unroll
        for (int i = 0; i < 8; ++i) { er[i] = e[(size_t)i * 128]; ei[i] = e[(size_t)i * 128 + 64]; }
        for (int ch0 = 0; ch0 < NCHK; ch0 += 8) {
#pragma unroll
            for (int i = 0; i < 8; ++i) { const int ch = ch0 + 8 + i; const bool ok = ch < NCHK; fr_[i] = ok ? e[(size_t)ch * 128] : 0.f; fi_[i] = ok ? e[(size_t)ch * 128 + 64] : 0.f; }
#pragma unroll
            for (int i = 0; i < 8; ++i) { const int ch = ch0 + i;
                if (ch < NCHK) { x[(size_t)ch * 384] = f2bf(xr); x[(size_t)ch * 384 + 64] = f2bf(xi);
                    const float nr = ar * xr - ai * xi + er[i], ni = ar * xi + ai * xr + ei[i]; xr = nr; xi = ni; } }
#pragma unroll
            for (int i = 0; i < 8; ++i) { er[i] = fr_[i]; ei[i] = fi_[i]; }
        }
    }
}

DI void hg_setup(KP p, int l, LAS unsigned char* L, bool valid, int row0, int clen, int h, int t2) {
    LAS float* cum = (LAS float*)(L + HG_CUM); LAS bf16_t* kraw = (LAS bf16_t*)(L + HG_KRAW); LAS bf16_t* vT = (LAS bf16_t*)(L + HG_VT);
    const bf16_t* zhg = (const bf16_t*)(p->ws + O_ZHG);
    {
        const int kc = t2 & 15;
        float lb[8];
#pragma unroll
        for (int i = 0; i < 8; ++i) lb[i] = 0.f;
        if (l == 1) { const float* lg = (const float*)p->in[19] + h * 128 + 8 * kc;
#pragma unroll
            for (int i = 0; i < 8; ++i) { const float x0 = lg[i], x1 = lg[512 + i]; const float mxx = fmaxf(x0, x1); const float e0 = __expf(x0 - mxx), e1 = __expf(x1 - mxx); lb[i] = e1 / (e0 + e1); } }
        u32x4 zw[4];
#pragma unroll
        for (int i = 0; i < 4; ++i) { const int s = (t2 >> 4) + 16 * i; zw[i] = (u32x4){0u, 0u, 0u, 0u};
            if (valid && s < clen) zw[i] = *(const u32x4*)(zhg + (size_t)(row0 + s) * 2048 + 512 + h * 128 + 8 * kc); }
        u32x4 vw[4];
#pragma unroll
        for (int i = 0; i < 4; ++i) { const int q = t2 + 256 * i, s = q & 63, vc = q >> 6; vw[i] = (u32x4){0u, 0u, 0u, 0u};
            if (valid && s < clen) vw[i] = *(const u32x4*)(zhg + (size_t)(row0 + s) * 2048 + 1024 + h * 128 + 8 * vc); }
#pragma unroll
        for (int i = 0; i < 4; ++i) {
            const int s = (t2 >> 4) + 16 * i; const bool in = valid && s < clen;
            const float z[8] = {bflo(zw[i].x), bfhi(zw[i].x), bflo(zw[i].y), bfhi(zw[i].y), bflo(zw[i].z), bfhi(zw[i].z), bflo(zw[i].w), bfhi(zw[i].w)};
            float lf[8], kk[8];
#pragma unroll
            for (int e = 0; e < 8; ++e) { const float sg = sigm(z[e]), f = lb[e] + (1.f - lb[e]) * sg; lf[e] = in ? __logf(fmaxf(f, 1e-6f)) : 0.f; kk[e] = in ? (1.f - lb[e]) * (1.f - sg) : 0.f; }
#pragma unroll
            for (int e = 0; e < 8; e += 2) *(LAS f32x2*)(cum + s * CUMP + 8 * kc + e) = (f32x2){lf[e], lf[e + 1]};
            u32x4 w; w.x = pk2(kk[0], kk[1]); w.y = pk2(kk[2], kk[3]); w.z = pk2(kk[4], kk[5]); w.w = pk2(kk[6], kk[7]);
            *(LAS u32x4*)(kraw + s * KRP + 8 * kc) = w;
        }
#pragma unroll
        for (int i = 0; i < 4; ++i) { const int q = t2 + 256 * i, s = q & 63, vc = q >> 6;
            const unsigned ww[4] = {vw[i].x, vw[i].y, vw[i].z, vw[i].w};
#pragma unroll
            for (int e = 0; e < 4; ++e) { vT[(8 * vc + 2 * e) * VTPP + s] = (bf16_t)(ww[e] & 0xffffu); vT[(8 * vc + 2 * e + 1) * VTPP + s] = (bf16_t)(ww[e] >> 16); } }
    }
    __syncthreads();
    if (t2 < 128) {
        float c = 0.f;
#pragma unroll 16
        for (int s = 0; s < 64; ++s) { c += cum[s * CUMP + t2]; cum[s * CUMP + t2] = c; }
    }
}
DI void hg_unit(int uidx, int& bh, int& c, int& row0, int& clen) { bh = uidx / HGC; c = uidx - bh * HGC; const int b = bh >> 2; row0 = b * LSEQ + (c == 0 ? 0 : 16 + 64 * (c - 1)); clen = c == 0 ? 16 : 64; }

DI void hg1_phase(KP p, int l, LAS unsigned char* lds) {
    p = kp_launder(p);
    const int tid = otid(), hw = tid >> 8, t2 = tid & 255, w4 = (tid >> 6) & 3, lane = tid & 63, fr = lane & 15, fq = lane >> 4;
    LAS unsigned char* L = lds + hw * HG_HALF;
    LAS float* cum = (LAS float*)(L + HG_CUM); LAS bf16_t* kraw = (LAS bf16_t*)(L + HG_KRAW); LAS bf16_t* vT = (LAS bf16_t*)(L + HG_VT);
    bf16_t* sloc = (bf16_t*)((unsigned char*)p->out + X_SLOC); float* dec = (float*)(p->ws + O_HGDEC);
    const int npairs = (64 * HGC + 1) / 2;
    for (int it = 0; it * (int)gridDim.x < npairs; ++it) {
        const int uidx = (it * gridDim.x + blockIdx.x) * 2 + hw; const bool valid = uidx < 64 * HGC;
        int bh, c, row0, clen; hg_unit(valid ? uidx : 0, bh, c, row0, clen); const int h = bh & 3;
        __syncthreads();
        hg_setup(p, l, L, valid, row0, clen, h, t2);
        __syncthreads();
        if (valid) {
            bf16x8 bfr[2][2];
#pragma unroll
            for (int nbi = 0; nbi < 2; ++nbi)
#pragma unroll
                for (int ks = 0; ks < 2; ++ks) {
                    const int dk = 16 * (2 * w4 + nbi) + fr; const float last = cum[63 * CUMP + dk]; float v[8];
#pragma unroll
                    for (int i = 0; i < 8; ++i) { const int s = 32 * ks + 8 * fq + i; v[i] = bf2f(kraw[s * KRP + dk]) * __expf(last - cum[s * CUMP + dk]); }
                    u32x4 w; w.x = pk2(v[0], v[1]); w.y = pk2(v[2], v[3]); w.z = pk2(v[4], v[5]); w.w = pk2(v[6], v[7]); bfr[nbi][ks] = __builtin_bit_cast(bf16x8, w);
                }
            bf16_t* dst = sloc + (size_t)(bh * HGC + c) * 128 * 128;
#pragma unroll
            for (int mb = 0; mb < 8; ++mb) {
                f32x4 a0 = {0.f, 0.f, 0.f, 0.f}, a1 = {0.f, 0.f, 0.f, 0.f};
#pragma unroll
                for (int ks = 0; ks < 2; ++ks) {
                    const bf16x8 af = *(const LAS bf16x8*)(vT + (16 * mb + fr) * VTPP + 32 * ks + 8 * fq);
                    a0 = __builtin_amdgcn_mfma_f32_16x16x32_bf16(af, bfr[0][ks], a0, 0, 0, 0);
                    a1 = __builtin_amdgcn_mfma_f32_16x16x32_bf16(af, bfr[1][ks], a1, 0, 0, 0);
                }
#pragma unroll
                for (int j = 0; j < 4; ++j) { const int dv = 16 * mb + 4 * fq + j;
                    dst[(size_t)dv * 128 + 16 * (2 * w4) + fr] = f2bf(a0[j]); dst[(size_t)dv * 128 + 16 * (2 * w4 + 1) + fr] = f2bf(a1[j]); }
            }
            if (t2 < 128) dec[(size_t)(bh * HGC + c) * 128 + t2] = __expf(cum[63 * CUMP + t2]);
        }
    }
    __syncthreads();
}

DI void hg2_phase(KP p, int gtid_, int gthreads) {
    p = kp_launder(p);
    const int gtid = blockIdx.x * 512 + otid(); gthreads = ogrid() * 512;
    bf16_t* sloc = (bf16_t*)((unsigned char*)p->out + X_SLOC); const float* dec = (const float*)(p->ws + O_HGDEC);
    for (int idx = gtid; idx < 64 * 128 * 16; idx += gthreads) {
        const int k8 = idx & 15, dv = (idx >> 4) & 127, bh = idx >> 11;
        float S[8];
#pragma unroll
        for (int i = 0; i < 8; ++i) S[i] = 0.f;
        bf16_t* base = sloc + ((size_t)(bh * HGC) * 128 + dv) * 128 + k8 * 8; const float* dbase = dec + (size_t)(bh * HGC) * 128 + k8 * 8;
        u32x4 wA[4], wB[4]; f32x4 dA[4][2], dB[4][2];
#pragma unroll
        for (int i = 0; i < 4; ++i) { wA[i] = *(const u32x4*)(base + (size_t)i * 16384); dA[i][0] = *(const f32x4*)(dbase + i * 128); dA[i][1] = *(const f32x4*)(dbase + i * 128 + 4); }
        for (int c0 = 0; c0 < HGC; c0 += 4) {
#pragma unroll
            for (int i = 0; i < 4; ++i) { const int c = c0 + 4 + i; if (c < HGC) { wB[i] = *(const u32x4*)(base + (size_t)c * 16384); dB[i][0] = *(const f32x4*)(dbase + c * 128); dB[i][1] = *(const f32x4*)(dbase + c * 128 + 4); } }
#pragma unroll
            for (int i = 0; i < 4; ++i) { const int c = c0 + i;
                if (c < HGC) {
                    u32x4 o; o.x = pk2(S[0], S[1]); o.y = pk2(S[2], S[3]); o.z = pk2(S[4], S[5]); o.w = pk2(S[6], S[7]);
                    *(u32x4*)(base + (size_t)c * 16384) = o;
                    const u32x4 w = wA[i]; const f32x4 d0 = dA[i][0], d1 = dA[i][1];
                    S[0] = d0[0] * S[0] + bflo(w.x); S[1] = d0[1] * S[1] + bfhi(w.x); S[2] = d0[2] * S[2] + bflo(w.y); S[3] = d0[3] * S[3] + bfhi(w.y);
                    S[4] = d1[0] * S[4] + bflo(w.z); S[5] = d1[1] * S[5] + bfhi(w.z); S[6] = d1[2] * S[6] + bflo(w.w); S[7] = d1[3] * S[7] + bfhi(w.w);
                } }
#pragma unroll
            for (int i = 0; i < 4; ++i) { wA[i] = wB[i]; dA[i][0] = dB[i][0]; dA[i][1] = dB[i][1]; }
        }
    }
}

DI void hg3_phase(KP p, int l, LAS unsigned char* lds) {
    p = kp_launder(p);
    const int tid = otid(), hw = tid >> 8, t2 = tid & 255, I = __builtin_amdgcn_readfirstlane((tid >> 6) & 3), lane = tid & 63, fr = lane & 15, fq = lane >> 4;
    LAS unsigned char* L = lds + hw * HG_HALF;
    LAS float* cum = (LAS float*)(L + HG_CUM); LAS bf16_t* kraw = (LAS bf16_t*)(L + HG_KRAW); LAS bf16_t* vT = (LAS bf16_t*)(L + HG_VT);
    const bf16_t* zhg = (const bf16_t*)(p->ws + O_ZHG); const bf16_t* st = (const bf16_t*)((unsigned char*)p->out + X_SLOC);
    bf16_t* hgout = (bf16_t*)(p->ws + O_HGOUT); const float* onorm = (const float*)p->in[20] + (size_t)l * 512;
    const int npairs = (64 * HGC + 1) / 2;
    for (int it = 0; it * (int)gridDim.x < npairs; ++it) {
        const int uidx = (it * gridDim.x + blockIdx.x) * 2 + hw; const bool valid = uidx < 64 * HGC;
        int bh, c, row0, clen; hg_unit(valid ? uidx : 0, bh, c, row0, clen); const int h = bh & 3;
        __syncthreads();
        hg_setup(p, l, L, valid, row0, clen, h, t2);
        __syncthreads();
        const int t = 16 * I + fr; const bool tv = valid && t < clen; const size_t row = (size_t)row0 + t;
        if (valid && 16 * I < clen) {
            bf16x8 qt[4], q2[4]; float Rr[4][8];
#pragma unroll
            for (int ks = 0; ks < 4; ++ks) {
                u32x4 qw = {0u, 0u, 0u, 0u}; if (tv) qw = *(const u32x4*)(zhg + row * 2048 + h * 128 + 32 * ks + 8 * fq);
                float q[8] = {bflo(qw.x), bfhi(qw.x), bflo(qw.y), bfhi(qw.y), bflo(qw.z), bfhi(qw.z), bflo(qw.w), bfhi(qw.w)};
                float a[8], bq[8];
#pragma unroll
                for (int i = 0; i < 8; ++i) { const int k = 32 * ks + 8 * fq + i; const float ct = cum[t * CUMP + k]; const float rr = I > 0 ? cum[(16 * I - 1) * CUMP + k] : 0.f; Rr[ks][i] = rr;
                    a[i] = q[i] * __expf(ct - rr); bq[i] = q[i] * __expf(ct); }
                u32x4 w; w.x = pk2(a[0], a[1]); w.y = pk2(a[2], a[3]); w.z = pk2(a[4], a[5]); w.w = pk2(a[6], a[7]); qt[ks] = __builtin_bit_cast(bf16x8, w);
                w.x = pk2(bq[0], bq[1]); w.y = pk2(bq[2], bq[3]); w.z = pk2(bq[4], bq[5]); w.w = pk2(bq[6], bq[7]); q2[ks] = __builtin_bit_cast(bf16x8, w);
            }
            f32x4 PT[4];
#pragma unroll
            for (int J = 0; J < 4; ++J) {
                PT[J] = (f32x4){0.f, 0.f, 0.f, 0.f};
                if (J <= I) {
#pragma unroll
                    for (int ks = 0; ks < 4; ++ks) {
                        const int s = 16 * J + fr; const u32x4 kw = *(const LAS u32x4*)(kraw + s * KRP + 32 * ks + 8 * fq);
                        float kk[8] = {bflo(kw.x), bfhi(kw.x), bflo(kw.y), bfhi(kw.y), bflo(kw.z), bfhi(kw.z), bflo(kw.w), bfhi(kw.w)};
#pragma unroll
                        for (int i = 0; i < 8; ++i) kk[i] *= __expf(Rr[ks][i] - cum[s * CUMP + 32 * ks + 8 * fq + i]);
                        u32x4 w; w.x = pk2(kk[0], kk[1]); w.y = pk2(kk[2], kk[3]); w.z = pk2(kk[4], kk[5]); w.w = pk2(kk[6], kk[7]);
                        PT[J] = __builtin_amdgcn_mfma_f32_16x16x32_bf16(__builtin_bit_cast(bf16x8, w), qt[ks], PT[J], 0, 0, 0);
                    }
                    if (J == I) {
#pragma unroll
                        for (int j = 0; j < 4; ++j) if (4 * fq + j > fr) PT[J][j] = 0.f;
                    }
                }
            }
            f32x4 acc[8];
#pragma unroll
            for (int mb = 0; mb < 8; ++mb) acc[mb] = (f32x4){0.f, 0.f, 0.f, 0.f};
#pragma unroll
            for (int pr = 0; pr < 2; ++pr) {
                const int J0 = 2 * pr;
                if (J0 <= I) {
                    u32x4 w; w.x = pk2(PT[J0][0], PT[J0][1]); w.y = pk2(PT[J0][2], PT[J0][3]); w.z = pk2(PT[J0 + 1][0], PT[J0 + 1][1]); w.w = pk2(PT[J0 + 1][2], PT[J0 + 1][3]);
                    const bf16x8 pf = __builtin_bit_cast(bf16x8, w);
#pragma unroll
                    for (int mb = 0; mb < 8; ++mb) {
                        const LAS bf16_t* vp = vT + (16 * mb + fr) * VTPP + 16 * J0 + 4 * fq;
                        const u32x2 lo = *(const LAS u32x2*)vp, hi = *(const LAS u32x2*)(vp + 16);
                        u32x4 a; a.x = lo.x; a.y = lo.y; a.z = hi.x; a.w = hi.y;
                        acc[mb] = __builtin_amdgcn_mfma_f32_16x16x32_bf16(__builtin_bit_cast(bf16x8, a), pf, acc[mb], 0, 0, 0);
                    }
                }
            }
            if (c > 0) {
                const bf16_t* sp = st + (size_t)(bh * HGC + c) * 128 * 128;
#pragma unroll
                for (int mb = 0; mb < 8; ++mb)
#pragma unroll
                    for (int ks = 0; ks < 4; ++ks) {
                        const bf16x8 af = *(const bf16x8*)(sp + (size_t)(16 * mb + fr) * 128 + 32 * ks + 8 * fq);
                        acc[mb] = __builtin_amdgcn_mfma_f32_16x16x32_bf16(af, q2[ks], acc[mb], 0, 0, 0);
                    }
            }
            float sq = 0.f;
#pragma unroll
            for (int mb = 0; mb < 8; ++mb) sq += acc[mb][0] * acc[mb][0] + acc[mb][1] * acc[mb][1] + acc[mb][2] * acc[mb][2] + acc[mb][3] * acc[mb][3];
            sq += __shfl_xor(sq, 16); sq += __shfl_xor(sq, 32);
            const float rs = rsqrtf(sq * (1.f / 128.f) + 1e-6f);
            if (tv) {
#pragma unroll
                for (int mb = 0; mb < 8; ++mb) {
                    const int dv = 16 * mb + 4 * fq;
                    const u32x2 gw = *(const u32x2*)(zhg + row * 2048 + 1536 + h * 128 + dv);
                    const f32x4 on = *(const f32x4*)(onorm + h * 128 + dv);
                    const float g0 = bflo(gw.x), g1 = bfhi(gw.x), g2 = bflo(gw.y), g3 = bfhi(gw.y);
                    u32x2 w; w.x = pk2(acc[mb][0] * rs * on[0] * g0 * sigm(g0), acc[mb][1] * rs * on[1] * g1 * sigm(g1));
                    w.y = pk2(acc[mb][2] * rs * on[2] * g2 * sigm(g2), acc[mb][3] * rs * on[3] * g3 * sigm(g3));
                    *(u32x2*)(hgout + row * 512 + h * 128 + dv) = w;
                }
            }
        }
    }
    __syncthreads();
}

#define XB_TMO      128
#define XB_XCNT(j)  (256  + 64 * (j))
#define XB_XSUB(j)  (1280 + 64 * (j))
#define XB_XGEN(j)  (2304 + 64 * (j))
#define XB_TOP      3328
#define XB_TOPGEN   3392
#define XCD_BAR_WORDS 3456
#define XB_SPIN_CAP (1u << 18)

__device__ __forceinline__ unsigned xb_ld(unsigned* p)              { return __hip_atomic_load(p, __ATOMIC_RELAXED, __HIP_MEMORY_SCOPE_AGENT); }
__device__ __forceinline__ unsigned xb_add(unsigned* p, unsigned v) { return __hip_atomic_fetch_add(p, v, __ATOMIC_RELAXED, __HIP_MEMORY_SCOPE_AGENT); }
__device__ __forceinline__ unsigned xb_xcc_id() { return (unsigned)__builtin_amdgcn_s_getreg((3 << 11) | 20) & 0xFu; }
#define XB_SPIN(cond, bar) do { unsigned _sp = 0; while (cond) { __builtin_amdgcn_s_sleep(1); \
    if ((++_sp & 255u) == 0u) { if (xb_ld(&(bar)[XB_TMO])) break; if (_sp > XB_SPIN_CAP) { atomicAdd(&(bar)[XB_TMO], 1u); break; } } } } while (0)

struct XcdBarrier {
    unsigned* bar; unsigned x;
    volatile LAS unsigned* st;
};

__device__ __forceinline__ XcdBarrier xcd_barrier_post(unsigned* bar, volatile LAS unsigned* st) {
    XcdBarrier b; b.bar = bar; b.x = xb_xcc_id(); b.st = st;
    if (threadIdx.x == 0) (void)xb_add(&bar[XB_XCNT(b.x)], 1u);
    return b;
}
__device__ __forceinline__ void xcd_barrier_complete(unsigned* bar, unsigned x, unsigned& nloc, unsigned& nx) {
    const unsigned G = gridDim.x * gridDim.y * gridDim.z;
    unsigned sum, cnt, mine, sp = 0u;
    for (;;) {
        sum = 0u; cnt = 0u; mine = 0u;
#pragma unroll
        for (unsigned j = 0; j < 16; ++j) { const unsigned c = xb_ld(&bar[XB_XCNT(j)]); sum += c; cnt += (c > 0u) ? 1u : 0u; mine = (j == x) ? c : mine; }
        if (sum == G) break;
        __builtin_amdgcn_s_sleep(1);
        if ((++sp & 255u) == 0u) { if (xb_ld(&bar[XB_TMO])) break; if (sp > XB_SPIN_CAP) { atomicAdd(&bar[XB_TMO], 1u); break; } }
    }
    nloc = mine > 0u ? mine : 1u; nx = cnt > 0u ? cnt : 1u;
}

__device__ __forceinline__ void xcd_barrier(const XcdBarrier& b) {
    asm volatile("s_waitcnt vmcnt(0)" ::: "memory");
    __syncthreads();
    if (threadIdx.x == 0) {
        unsigned* bar = b.bar;
        __builtin_amdgcn_s_waitcnt(0);
        unsigned nloc = b.st[0], nx = b.st[1];
        if (nloc == 0u) { xcd_barrier_complete(bar, b.x, nloc, nx); b.st[0] = nloc; b.st[1] = nx; }
        const unsigned old = xb_add(&bar[XB_XSUB(b.x)], 1u);
        const unsigned gen = old / nloc;
        if (old + 1u == (gen + 1u) * nloc) {
            __builtin_amdgcn_fence(__ATOMIC_RELEASE, "agent");
            asm volatile("s_waitcnt vmcnt(0)" ::: "memory");
            const unsigned og = xb_add(&bar[XB_TOP], 1u);
            const unsigned tg = og / nx;
            if (og + 1u == (tg + 1u) * nx) xb_add(&bar[XB_TOPGEN], 1u);
            else XB_SPIN(xb_ld(&bar[XB_TOPGEN]) == tg, bar);
            __builtin_amdgcn_fence(__ATOMIC_ACQUIRE, "agent");
            xb_add(&bar[XB_XGEN(b.x)], 1u);
            asm volatile("s_waitcnt vmcnt(0)" ::: "memory");
        } else {
            XB_SPIN(xb_ld(&bar[XB_XGEN(b.x)]) == gen, bar);
            __builtin_amdgcn_fence(__ATOMIC_ACQUIRE, "agent");
            asm volatile("s_waitcnt vmcnt(0)" ::: "memory");
        }
    }
    __syncthreads();
}


__global__ void __launch_bounds__(512, 2) fwd_megakernel(Params p_args) {
    KP p = kparams();
    extern __shared__ __attribute__((aligned(16))) unsigned char smem[];
    LAS unsigned char* lds = (LAS unsigned char*)smem;
    cg::grid_group grid = cg::this_grid();
    const int tid = threadIdx.x, wid = __builtin_amdgcn_readfirstlane(tid >> 6), lane = tid & 63;
    const int G = gridDim.x, c = blockIdx.x, gtid = c * 512 + tid, gthreads = G * 512, gwave = c * 8 + wid, nwaves = G * 8;
    unsigned char* ws = p->ws; unsigned char* xo = (unsigned char*)p->out;
    float* hres = (float*)(ws + O_HRES); float* ssq = (float*)(ws + O_SSQ);
    const float* cosT = (const float*)(ws + O_COS); const float* sinT = (const float*)(ws + O_SIN);

    if (c == 0) for (int i = tid; i < 4096; i += 512) __hip_atomic_store((unsigned*)(p->ws + O_BAR) + i, 0u, __ATOMIC_RELAXED, __HIP_MEMORY_SCOPE_AGENT);
    if (tid < 2) ((volatile LAS unsigned*)(lds + LDS_BARST))[tid] = 0u;
#if PH_PRO
    convert_weights(p, 0, 0, lds);
    convert_weights(p, 0, 1, lds);
    s5_build(p, 0, lds);
#endif
    ln_rows(p, 0, (const float*)p->in[3], (const float*)p->in[4], gwave, nwaves, lane);
    for (int idx = c * 512 + otid(); idx < T * 16; idx += ogrid() * 512) {
        const int r = idx >> 4, i = idx & 15, b = r / LSEQ, tt = r - b * LSEQ;
        const int pos = tt < 16 ? tt : ((const int*)p->in[1])[b * 2048 + tt - 16] + 16;
        const float inv = expf(-(float)i * (1.f / 16.f) * 9.210340371976184f);
        float s, cc; sincosf((float)pos * inv, &s, &cc);
        ((float*)(ws + O_COS))[idx] = cc; ((float*)(ws + O_SIN))[idx] = s;
    }
    for (int idx = c * 512 + otid(); idx < 2 * T; idx += ogrid() * 512) ssq[idx] = 0.f;
    for (int idx = c * 512 + otid(); idx < 8 * T; idx += ogrid() * 512) ((float*)(ws + O_STATS))[idx] = 0.f;
    grid.sync();
    const XcdBarrier xbar = xcd_barrier_post((unsigned*)(p->ws + O_BAR), (volatile LAS unsigned*)(lds + LDS_BARST));
#define WSP unsigned char* ws = kp_launder(p)->ws; unsigned char* xo = (unsigned char*)kp_launder(p)->out; (void)xo;
#define STATS(slot) ((float*)(ws + O_STATS) + (size_t)(slot) * T * 2)
#define COLV(off) ((const float*)(ws + O_COLV) + (off))

    for (int l = 0; l < 2; ++l) {
        { WSP
          pg8::SchedGrid S{(const char*)(ws + O_HBF), (const char*)(ws + W_WIN), 1024, 1024, 16, 129, 13, ogrid(), obid()};
          EpiA E{(bf16_t*)(xo + X_UG), (bf16_t*)(ws + O_ZHG), (bf16_t*)(ws + O_CQKV), (bf16_t*)(ws + O_KR), (float*)(ws + O_SSQ), (const float*)(ws + O_COS), (const float*)(ws + O_SIN),
                 l > 0 ? STATS(2 * l - 1) : (const float*)nullptr, COLV(CV_IN), COLV(CV_IN + 3328)};
          pg8::gemm_phase(lds, S, E);
          if (l == 1) convert_weights(p, 1, 1, lds); }
        xcd_barrier(xbar);
        { WSP
          EpiB E{(bf16_t*)(xo + X_QA), (bf16_t*)(ws + O_KA), (bf16_t*)(ws + O_VT), (float*)(ws + O_EBUF), (const float*)(ws + O_SSQ), (const float*)(ws + O_COS), (const float*)(ws + O_SIN)};
          pg8::gemm_phase(lds, SchedB{(const char*)(ws + O_CQKV), (const char*)(ws + W_WUQ), 512, 256, 4, 0, ogrid(), obid()}, E);
          pg8::gemm_phase(lds, SchedB{(const char*)(ws + O_CQKV) + 512, (const char*)(ws + W_WK), 512, 256, 4, 1, ogrid(), obid()}, E);
          pg8::gemm_phase(lds, SchedB{(const char*)(ws + W_WV), (const char*)(ws + O_CQKV) + 512, 256, 512, 4, 2, ogrid(), obid()}, E);
          pg8::gemm_phase(lds, SchedS5{(const char*)(xo + X_UG), (const char*)(ws + W_MB), 384, 256, 4, 3, ogrid(), obid()}, E); }
        xcd_barrier(xbar);
        if (otid() < 128) s5_scan(p, 0, G * 128);
        attention_phase(p, lds);
        { float* ssq = (float*)(kp_launder(p)->ws + O_SSQ); for (int idx = obid() * 512 + otid(); idx < 2 * T; idx += ogrid() * 512) ssq[idx] = 0.f; }
        xcd_barrier(xbar);
        { WSP
          pg8::gemm_phase(lds, SchedS5{(const char*)(xo + X_UG), (const char*)(ws + W_MD), 384, 384, 6, 0, ogrid(), obid()}, EpiS5Y{(bf16_t*)(ws + O_YGELU)}); }
        hg1_phase(p, l, lds);
        xcd_barrier(xbar);
        { WSP
          pg8::SchedGrid S{(const char*)(ws + O_YGELU), (const char*)(ws + W_WGLU), 512, 512, 8, 129, 2, ogrid(), obid()};
          pg8::gemm_phase(lds, S, EpiGlu{(const bf16_t*)(ws + O_YGELU), (bf16_t*)(ws + O_S5OUT)}); }
        hg2_phase(p, gtid, gthreads);
        xcd_barrier(xbar);
        hg3_phase(p, l, lds);
        xcd_barrier(xbar);
        { WSP
          EpiF E{(bf16_t*)(ws + O_GATEB), (bf16_t*)(ws + O_MIXED), l > 0 ? STATS(2 * l - 1) : (const float*)nullptr, COLV(CV_GATE), COLV(CV_GATE + 3072), (unsigned*)(ws + O_BAR) + 3520, 48u * (unsigned)l};
          const char* brp[3] = {(const char*)(ws + O_O), (const char*)(ws + O_S5OUT), (const char*)(ws + O_HGOUT)};
#pragma unroll
          for (int br = 0; br < 3; ++br) {
              pg8::gemm_phase(lds, SchedF{(const char*)(ws + O_HBF), (const char*)(ws + W_WGATE) + (size_t)br * 1024 * 1024 * 2, 1024, 1024, 16, 2 * br, ogrid(), obid()}, E);
              pg8::gemm_phase(lds, SchedF{brp[br], (const char*)(ws + W_WBR) + (size_t)br * 1024 * 512 * 2, 512, 512, 8, 2 * br + 1, ogrid(), obid()}, E);
          } }
        xcd_barrier(xbar);
        { WSP
          pg8::SchedGrid S{(const char*)(ws + O_MIXED), (const char*)(ws + W_WOUT), 1024, 1024, 16, 129, 4, ogrid(), obid()};
          EpiRes E{(float*)(ws + O_HRES), (bf16_t*)(ws + O_HBF), l > 0 ? STATS(2 * l - 1) : (const float*)nullptr, (const float*)kp_launder(p)->in[30] + (l - 1) * 1024, (const float*)kp_launder(p)->in[31] + (l - 1) * 1024, STATS(2 * l)};
          pg8::gemm_phase(lds, S, E); }
        xcd_barrier(xbar);
        { WSP
          pg8::SchedGrid S{(const char*)(ws + O_HBF), (const char*)(ws + W_WGU), 1024, 1024, 16, 129, 22, ogrid(), obid()};
          pg8::gemm_phase(lds, S, EpiFfn1{(bf16_t*)(ws + O_HFF), STATS(2 * l), COLV(CV_GU), COLV(CV_GU + 5632)});
          if (l == 0) { convert_weights(p, 1, 0, lds); s5_build(p, 1, lds); } }
        xcd_barrier(xbar);
        { WSP
          pg8::SchedGrid S{(const char*)(ws + O_HFF), (const char*)(ws + W_WD), DFF, DFF, 44, 129, 4, ogrid(), obid()};
          EpiRes E{(float*)(ws + O_HRES), (bf16_t*)(ws + O_HBF), STATS(2 * l), (const float*)kp_launder(p)->in[25] + l * 1024, (const float*)kp_launder(p)->in[26] + l * 1024, STATS(2 * l + 1)};
          pg8::gemm_phase(lds, S, E); }
        xcd_barrier(xbar);
    }
    ln_rows(p, 2, (const float*)p->in[30] + 1024, (const float*)p->in[31] + 1024, gwave, nwaves, lane);
}

extern "C" void kernel_launch(void* const* d_in, const int* in_sizes, int n_in, void* d_out, int out_size, void* d_ws, size_t ws_size, hipStream_t stream) {
    static int grid_blocks = 0;
    if (!grid_blocks) {
        int dev = 0, cus = 0, per_cu = 0;
        hipGetDevice(&dev);
        hipDeviceGetAttribute(&cus, hipDeviceAttributeMultiprocessorCount, dev);
        hipFuncSetAttribute((const void*)fwd_megakernel, hipFuncAttributeMaxDynamicSharedMemorySize, LDS_BYTES);
        hipOccupancyMaxActiveBlocksPerMultiprocessor(&per_cu, (const void*)fwd_megakernel, 512, LDS_BYTES);
        if (per_cu < 1) per_cu = 1;
        if (per_cu > 1) per_cu = 1;
        grid_blocks = cus * per_cu;
        if (ws_size < O_WSEND) fprintf(stderr, "kernel_launch: workspace too small: %zu < %zu\n", ws_size, (size_t)O_WSEND);
    }
    Params p{};
    for (int i = 0; i < 32; ++i) p.in[i] = d_in[i];
    p.out = (float*)d_out; p.ws = (unsigned char*)d_ws;
    void* args[] = {&p};
    hipError_t e = hipLaunchCooperativeKernel((const void*)fwd_megakernel, dim3(grid_blocks), dim3(512), args, LDS_BYTES, stream);
    if (e != hipSuccess) fprintf(stderr, "cooperative launch failed: %s (grid %d)\n", hipGetErrorString(e), grid_blocks);
}
```

```cpp
#include <hip/hip_runtime.h>
#include <hip/hip_cooperative_groups.h>
#include <cstdint>
#include <cstdio>
namespace cg = cooperative_groups;
#ifndef DBL_C
#define DBL_C 0
#endif
#ifndef DBL_HG
#define DBL_HG 0
#endif
#ifndef PH_PRO
#define PH_PRO 1
#endif
#ifndef PH_A
#define PH_A 1
#endif
#ifndef PH_B
#define PH_B 1
#endif
#ifndef PH_C
#define PH_C 1
#endif
#ifndef PH_D
#define PH_D 1
#endif
#ifndef PH_HG1
#define PH_HG1 1
#endif
#ifndef PH_E
#define PH_E 1
#endif
#ifndef PH_HG3
#define PH_HG3 1
#endif
#ifndef PH_F
#define PH_F 1
#endif
#ifndef PH_G
#define PH_G 1
#endif
#ifndef PH_I
#define PH_I 1
#endif
#ifndef PH_J
#define PH_J 1
#endif

#define DI __device__ __forceinline__
#define LAS __attribute__((address_space(3)))
typedef unsigned short bf16_t;
typedef short bf16x8 __attribute__((ext_vector_type(8)));
typedef float f32x4 __attribute__((ext_vector_type(4)));
typedef float f32x2 __attribute__((ext_vector_type(2)));
typedef float f32x16 __attribute__((ext_vector_type(16)));
typedef unsigned u32x4 __attribute__((ext_vector_type(4)));
typedef unsigned u32x2 __attribute__((ext_vector_type(2)));
typedef __bf16 bfv2 __attribute__((ext_vector_type(2)));

constexpr int NB = 16, LSEQ = 2064, T = NB * LSEQ, DM = 1024, DFF = 2816;
constexpr int NCHK = 129;
constexpr int SROWS = 2304;
constexpr int HGC = 33;
constexpr float ALPHA = 1.41421356237309515f;
constexpr float QSCALE = 0.10206207261596575f * 1.4426950408889634f;

constexpr size_t al256(size_t x) { return (x + 255) & ~(size_t)255; }
constexpr size_t W_WIN = 0;
constexpr size_t W_WGATE = W_WIN + (size_t)3328 * 1024 * 2;
constexpr size_t W_WUQ = W_WGATE + (size_t)3072 * 1024 * 2;
constexpr size_t W_WK = W_WUQ + (size_t)768 * 256 * 2;
constexpr size_t W_WV = W_WK + (size_t)512 * 256 * 2;
constexpr size_t W_WGLU = W_WV + (size_t)512 * 256 * 2;
constexpr size_t W_WBR = W_WGLU + (size_t)512 * 512 * 2;
constexpr size_t W_WOUT = W_WBR + (size_t)3 * 1024 * 512 * 2;
constexpr size_t W_WGU = W_WOUT + (size_t)1024 * 1024 * 2;
constexpr size_t W_WD = W_WGU + (size_t)5632 * 1024 * 2;
constexpr size_t W_MB = W_WD + (size_t)1024 * 2816 * 2;
constexpr size_t W_MD = W_MB + (size_t)32 * 256 * 256 * 2;
constexpr size_t W_A16 = W_MD + (size_t)32 * 256 * 384 * 2;
constexpr size_t W_END = W_A16 + (size_t)32 * 64 * 2 * 4;
constexpr size_t O_HRES = al256(W_END);
constexpr size_t O_HBF = O_HRES + (size_t)T * 1024 * 4;
constexpr size_t O_COS = O_HBF + (size_t)T * 1024 * 2;
constexpr size_t O_SIN = O_COS + (size_t)T * 16 * 4;
constexpr size_t O_SSQ = O_SIN + (size_t)T * 16 * 4;
constexpr size_t O_HGDEC = al256(O_SSQ + (size_t)2 * T * 4);
constexpr size_t O_ZHG = al256(O_HGDEC + (size_t)64 * HGC * 128 * 4);
constexpr size_t O_CQKV = O_ZHG + (size_t)T * 2048 * 2;
constexpr size_t O_KA = O_CQKV + (size_t)T * 512 * 2;
constexpr size_t O_VT = O_KA + (size_t)T * 512 * 2 + 65536;
constexpr size_t O_EBUF = O_VT + (size_t)T * 512 * 2 + 65536;
constexpr size_t O_KR = O_EBUF + (size_t)32 * LSEQ * 128 * 4;
constexpr size_t O_BAR = O_KR + (size_t)T * 32 * 2 + 65536;
constexpr size_t O_STATS = O_BAR + 16384;
constexpr size_t O_COLV = O_STATS + (size_t)4 * T * 2 * 4;
constexpr int CV_IN = 0, CV_GATE = 2 * 3328, CV_GU = CV_GATE + 2 * 3072, CV_TOTAL = CV_GU + 2 * 5632;
constexpr size_t O_WSEND = O_COLV + (size_t)CV_TOTAL * 4 + 256;
constexpr size_t O_O = O_CQKV, O_S5OUT = O_KA, O_HGOUT = O_VT, O_YGELU = O_EBUF, O_GATEB = O_ZHG, O_MIXED = O_ZHG + (size_t)T * 1024 * 2, O_HFF = O_ZHG;
constexpr size_t X_UG = 0;
constexpr size_t X_QA = (size_t)32 * SROWS * 384 * 2;
constexpr size_t X_SLOC = X_QA;
static_assert(X_SLOC + (size_t)64 * HGC * 128 * 128 * 2 <= (size_t)NB * 2048 * 1024 * 4, "sloc fits d_out");
static_assert(X_QA + (size_t)(T + 16) * 768 * 2 <= (size_t)NB * 2048 * 1024 * 4, "qa fits d_out");
static_assert(O_WSEND <= (size_t)4 * NB * 2048 * 1024 * 4, "ws fits");
static_assert((size_t)T * 2816 * 2 <= (size_t)T * (2048 + 512 + 512) * 2, "hff fits");
constexpr int VTP = T;

constexpr int LDS_BYTES = 138240 + 16, LDS_BARST = 138240;
constexpr int HG_HALF = 69120, HG_CUM = 0, HG_KRAW = 33280, HG_VT = 50688, CUMP = 130, KRP = 136, VTPP = 72;

struct Params { const void* in[32]; float* out; unsigned char* ws; };
typedef const __attribute__((address_space(4))) Params* KP;
__device__ __forceinline__ KP kp_launder(KP q) { asm volatile("" : "+s"(q)); return q; }
__device__ __forceinline__ KP kparams() { return kp_launder((KP)__builtin_amdgcn_kernarg_segment_ptr()); }

DI int otid() { int t = threadIdx.x; asm volatile("" : "+v"(t)); return t; }
DI int obid() { int b = blockIdx.x; asm volatile("" : "+s"(b)); return b; }
DI int ogrid() { int g = gridDim.x; asm volatile("" : "+s"(g)); return g; }
DI unsigned pk2(float lo, float hi) { f32x2 v = {lo, hi}; bfv2 b = __builtin_convertvector(v, bfv2); return __builtin_bit_cast(unsigned, b); }
DI bf16_t f2bf(float x) { return (bf16_t)(pk2(x, 0.f) & 0xffffu); }
DI float bf2f(bf16_t b) { return __uint_as_float((unsigned)b << 16); }
DI float bflo(unsigned w) { return __uint_as_float(w << 16); }
DI float bfhi(unsigned w) { return __uint_as_float(w & 0xffff0000u); }
DI float sigm(float x) { return 1.f / (1.f + __expf(-x)); }
DI float gelu_tanh(float x) { const float u = 0.7978845608028654f * (x + 0.044715f * x * x * x); const float t = 1.f - 2.f / (1.f + __expf(2.f * u)); return 0.5f * x * (1.f + t); }
DI u32x4 pack8(const f32x4 a, const f32x4 b) { u32x4 w; w.x = pk2(a[0], a[1]); w.y = pk2(a[2], a[3]); w.z = pk2(b[0], b[1]); w.w = pk2(b[2], b[3]); return w; }

DI void ln_stats(const float* st, int r, float& mu, float& rs) { const f32x2 v = *(const f32x2*)(st + (size_t)r * 2); mu = v.x * (1.f / 1024.f); rs = rsqrtf(fmaxf(v.y * (1.f / 1024.f) - mu * mu, 0.f) + 1e-5f); }
DI void ln_fix(f32x4& v0, f32x4& v1, float mu, float rs, const float* cs, const float* bw, int col) {
    const f32x4 c0 = *(const f32x4*)(cs + col), c1 = *(const f32x4*)(cs + col + 4), b0 = *(const f32x4*)(bw + col), b1 = *(const f32x4*)(bw + col + 4);
    v0 = (v0 - c0 * mu) * rs + b0; v1 = (v1 - c1 * mu) * rs + b1; }

struct CV4 { f32x4 c0, c1, b0, b1; };
DI CV4 cv_load(const float* cs, const float* bw, int col) { CV4 v; v.c0 = *(const f32x4*)(cs + col); v.c1 = *(const f32x4*)(cs + col + 4); v.b0 = *(const f32x4*)(bw + col); v.b1 = *(const f32x4*)(bw + col + 4); return v; }
DI void ln_fix2(f32x4& v0, f32x4& v1, float mu, float rs, const CV4& c) { v0 = (v0 - c.c0 * mu) * rs + c.b0; v1 = (v1 - c.c1 * mu) * rs + c.b1; }

namespace pg8 {
constexpr int BM = 256, BK = 64, HALF = 128, HTB = HALF * BK * 2, STAGE_BYTES = 8 * HTB;
DI int lds_byte(int r, int c) { const int st = (r >> 4) * 2 + (c >> 5), rr = r & 15, cc = c & 31, ob = rr * 64 + cc * 2; return st * 1024 + (ob ^ (((ob >> 9) & 1) << 5)); }
DI void stage_rc(int b, int& R, int& C) { const int st = b / 1024, sb = b % 1024, swz = sb ^ (((sb >> 9) & 1) << 5); R = (st >> 1) * 16 + swz / 64; C = (st & 1) * 32 + (swz % 64) / 2; }
DI int perm32(int rho) { const int n = rho >> 4, i = rho & 15; return 8 * (i >> 2) + 4 * n + (i & 3); }

struct GUnit { const char* a; const char* b; int pm, pn, tag; };

template <class Epi, class Sched>
DI void gemm_phase(LAS unsigned char* lds, const Sched& S, const Epi& E) {
    const int tid = otid(), wid = __builtin_amdgcn_readfirstlane(tid >> 6), lane = tid & 63, wr = wid >> 2, wc = wid & 3, fr = lane & 15, fq = lane >> 4;
    int sR[2], sC[2], sRb[2];
#pragma unroll
    for (int i = 0; i < 2; ++i) { int R, C; stage_rc(tid * 16 + i * 8192, R, C); sR[i] = R; sC[i] = C; sRb[i] = (R & ~31) + perm32(R & 31); }
    const size_t kstep = (size_t)(BK * 2);
    const unsigned ldsw = (unsigned)wid * 1024u;
    const int aoff = lds_byte(wr * 64 + fr, fq * 8), boff = lds_byte(wc * 32 + fr, fq * 8);
#define PG8_SA(b, h) (((b) * 2 + (h)) * HTB)
#define PG8_SB(b, h) ((4 + (b) * 2 + (h)) * HTB)
#define PG8_STAGE(bufoff, gbase, v0, v1) do { \
        __builtin_amdgcn_global_load_lds((const unsigned*)((const char*)(gbase) + (v0)), (LAS unsigned*)(lds + (bufoff) + ldsw), 16, 0, 0); \
        __builtin_amdgcn_global_load_lds((const unsigned*)((const char*)(gbase) + (v1)), (LAS unsigned*)(lds + (bufoff) + ldsw + 8192), 16, 0, 0); } while (0)
#define PG8_LDA(dst, b, h) do { _Pragma("unroll") for (int m = 0; m < 4; ++m) _Pragma("unroll") for (int k = 0; k < 2; ++k) dst[m][k] = *(const LAS bf16x8*)(lds + PG8_SA(b, h) + aoff + m * 2048 + k * 1024); } while (0)
#define PG8_LDB(dst, b, h) do { _Pragma("unroll") for (int n = 0; n < 2; ++n) _Pragma("unroll") for (int k = 0; k < 2; ++k) dst[n][k] = *(const LAS bf16x8*)(lds + PG8_SB(b, h) + boff + n * 2048 + k * 1024); } while (0)
#define PG8_MMA(ai, bj, At, Bt) do { __builtin_amdgcn_s_setprio(1); _Pragma("unroll") for (int m = 0; m < 4; ++m) _Pragma("unroll") for (int n = 0; n < 2; ++n) _Pragma("unroll") for (int k = 0; k < 2; ++k) \
        acc[ai][bj][m][n] = __builtin_amdgcn_mfma_f32_16x16x32_bf16(Bt[n][k], At[m][k], acc[ai][bj][m][n], 0, 0, 0); __builtin_amdgcn_s_setprio(0); } while (0)
#define PG8_WAIT_V(n) asm volatile("s_waitcnt vmcnt(" #n ")" ::: "memory")
#define PG8_WAIT_L(n) asm volatile("s_waitcnt lgkmcnt(" #n ")" ::: "memory")
#define PG8_BAR __builtin_amdgcn_s_barrier()
#define PG8_SCHED __builtin_amdgcn_sched_barrier(0)
    GUnit cur, nxt; int ui = 0;
    if (!S.next(0, cur)) return;
    f32x4 acc[2][2][4][2];
#pragma unroll
    for (int a = 0; a < 2; ++a)
#pragma unroll
        for (int b = 0; b < 2; ++b)
#pragma unroll
            for (int m = 0; m < 4; ++m)
#pragma unroll
                for (int n = 0; n < 2; ++n) acc[a][b][m][n] = (f32x4){0.f, 0.f, 0.f, 0.f};
    bf16x8 At[4][2], B0[2][2], B1[2][2];
    const char* cA = cur.a; const char* cB = cur.b;
    const int lda = S.lda, ldb = S.ldb, nt = S.nt;
    const unsigned vA0 = (unsigned)(sR[0] * lda + sC[0]) * 2u, vA1 = (unsigned)(sR[1] * lda + sC[1]) * 2u;
    const unsigned vB0 = (unsigned)(sRb[0] * ldb + sC[0]) * 2u, vB1 = (unsigned)(sRb[1] * ldb + sC[1]) * 2u;
    const size_t hA = (size_t)HALF * lda * 2, hB = (size_t)HALF * ldb * 2;
    PG8_STAGE(PG8_SB(0, 0), cB, vB0, vB1); PG8_STAGE(PG8_SB(0, 1), cB + hB, vB0, vB1); PG8_STAGE(PG8_SA(0, 0), cA, vA0, vA1); PG8_STAGE(PG8_SA(0, 1), cA + hA, vA0, vA1);
    if (wr == 1) PG8_BAR;
    PG8_WAIT_V(2); PG8_BAR;
    PG8_STAGE(PG8_SB(1, 0), cB + kstep, vB0, vB1); PG8_STAGE(PG8_SA(1, 0), cA + kstep, vA0, vA1); PG8_STAGE(PG8_SB(1, 1), cB + hB + kstep, vB0, vB1);
    PG8_WAIT_V(6); PG8_BAR;
    for (;;) {
        const bool has_next = S.next(ui + 1, nxt);
        const char* nA = has_next ? nxt.a : cA; const char* nB = has_next ? nxt.b : cB;
        for (int t = 0; t < nt; t += 2) {
            const bool last = (t == nt - 2);
            const char* a1 = cA + (size_t)(t + 1) * kstep;
            const char* a2 = last ? nA : cA + (size_t)(t + 2) * kstep; const char* b2 = last ? nB : cB + (size_t)(t + 2) * kstep;
            const char* a3 = a2 + kstep; const char* b3 = b2 + kstep;
            PG8_LDB(B0, 0, 0); PG8_LDB(B1, 0, 1); PG8_SCHED; PG8_LDA(At, 0, 0); PG8_STAGE(PG8_SA(1, 1), a1 + hA, vA0, vA1);
            PG8_WAIT_V(8); PG8_WAIT_L(0); PG8_BAR; PG8_MMA(0, 0, At, B0); PG8_MMA(0, 1, At, B1); PG8_BAR; PG8_SCHED;
            PG8_LDA(At, 0, 1); PG8_STAGE(PG8_SB(0, 0), b2, vB0, vB1); PG8_STAGE(PG8_SB(0, 1), b2 + hB, vB0, vB1); PG8_STAGE(PG8_SA(0, 0), a2, vA0, vA1);
            PG8_WAIT_V(8); PG8_WAIT_L(0); PG8_BAR; PG8_MMA(1, 0, At, B0); PG8_MMA(1, 1, At, B1); PG8_BAR; PG8_SCHED;
            PG8_LDB(B0, 1, 0); PG8_LDB(B1, 1, 1); PG8_SCHED; PG8_LDA(At, 1, 0); PG8_STAGE(PG8_SA(0, 1), a2 + hA, vA0, vA1);
            PG8_WAIT_V(8); PG8_WAIT_L(0); PG8_BAR; PG8_MMA(0, 0, At, B0); PG8_MMA(0, 1, At, B1); PG8_BAR; PG8_SCHED;
            PG8_LDA(At, 1, 1); PG8_STAGE(PG8_SB(1, 0), b3, vB0, vB1); PG8_STAGE(PG8_SB(1, 1), b3 + hB, vB0, vB1); PG8_STAGE(PG8_SA(1, 0), a3, vA0, vA1);
            PG8_WAIT_V(8); PG8_WAIT_L(0); PG8_BAR; PG8_MMA(1, 0, At, B0); PG8_MMA(1, 1, At, B1); PG8_BAR; PG8_SCHED;
        }
        if (wr == 0) PG8_BAR;
        E(acc, cur, wr, wc, fr, fq);
        if (!has_next) break;
#pragma unroll
        for (int a = 0; a < 2; ++a)
#pragma unroll
            for (int b = 0; b < 2; ++b)
#pragma unroll
                for (int m = 0; m < 4; ++m)
#pragma unroll
                    for (int n = 0; n < 2; ++n) acc[a][b][m][n] = (f32x4){0.f, 0.f, 0.f, 0.f};
        cur = nxt; cA = nA; cB = nB; ++ui;
        if (wr == 1) PG8_BAR;
    }
    PG8_WAIT_V(0);
    PG8_BAR;
#undef PG8_SA
#undef PG8_SB
#undef PG8_STAGE
#undef PG8_LDA
#undef PG8_LDB
#undef PG8_MMA
#undef PG8_WAIT_V
#undef PG8_WAIT_L
#undef PG8_BAR
#undef PG8_SCHED
}

struct SchedGrid {
    const char* A; const char* B; int lda, ldb, nt, nM, nN, G, c;
    DI bool next(int i, GUnit& u) const {
        const int nwg = nM * nN; const long L = (long)i * G + c; if (L >= nwg) return false;
        int wgid = (int)L; { const int q = nwg / 8, r = nwg % 8, xcd = wgid % 8, off = wgid / 8; wgid = (xcd < r ? xcd * (q + 1) : r * (q + 1) + (xcd - r) * q) + off; }
        const int nig = 8 * nN, gid = wgid / nig, fm = gid * 8, gsz = (nM - fm) < 8 ? (nM - fm) : 8;
        u.pm = fm + ((wgid % nig) % gsz); u.pn = (wgid % nig) / gsz;
        u.a = A + (size_t)u.pm * 256 * lda * 2; u.b = B + (size_t)u.pn * 256 * ldb * 2; u.tag = 0; return true;
    }
};
}
using pg8::GUnit;

#define EPI_ROWS(ai, m) (u.pm * 256 + (ai) * 128 + wr * 64 + (m) * 16 + fr)
#define EPI_COL(bj) (u.pn * 256 + (bj) * 128 + wc * 32 + 8 * fq)

struct EpiA {
    bf16_t* ug; bf16_t* zhg; bf16_t* cqkv; bf16_t* kr; float* ssq; const float* cosT; const float* sinT; const float* st; const float* cs; const float* bw;
    DI void operator()(const f32x4 (&acc_)[2][2][4][2], const GUnit& u, int wr, int wc, int fr, int fq) const {
        const int pn = u.pn;
        CV4 cv0, cv1; if (st) { cv0 = cv_load(cs, bw, EPI_COL(0)); cv1 = cv_load(cs, bw, EPI_COL(1)); }
#pragma unroll
        for (int ai = 0; ai < 2; ++ai)
#pragma unroll
            for (int m = 0; m < 4; ++m) {
                const int r = EPI_ROWS(ai, m);
                f32x4 acc[2][2][4][2];
                acc[ai][0][m][0] = acc_[ai][0][m][0]; acc[ai][0][m][1] = acc_[ai][0][m][1]; acc[ai][1][m][0] = acc_[ai][1][m][0]; acc[ai][1][m][1] = acc_[ai][1][m][1];
                if (st) { float mu, rs; ln_stats(st, r, mu, rs);
                    ln_fix2(acc[ai][0][m][0], acc[ai][0][m][1], mu, rs, cv0); ln_fix2(acc[ai][1][m][0], acc[ai][1][m][1], mu, rs, cv1); }
                if (pn < 2) {
                    const int b = r / LSEQ, tt = r - b * LSEQ, chunk = tt >> 4, s = tt & 15;
#pragma unroll
                    for (int bj = 0; bj < 2; ++bj) { const int col = EPI_COL(bj); const int g = col >> 4, c = col & 15;
                        *(u32x4*)(ug + ((size_t)(g * SROWS + b * NCHK + chunk) * 384 + s * 16 + c)) = pack8(acc[ai][bj][m][0], acc[ai][bj][m][1]); }
                } else if (pn < 10) {
#pragma unroll
                    for (int bj = 0; bj < 2; ++bj) { const int col = EPI_COL(bj) - 512;
                        *(u32x4*)(zhg + ((size_t)r * 2048 + col)) = pack8(acc[ai][bj][m][0], acc[ai][bj][m][1]); }
                } else if (pn < 12) {
                    float sq = 0.f;
#pragma unroll
                    for (int bj = 0; bj < 2; ++bj) { const int col = EPI_COL(bj) - 2560;
                        const f32x4 v0 = acc[ai][bj][m][0], v1 = acc[ai][bj][m][1];
                        sq += v0[0] * v0[0] + v0[1] * v0[1] + v0[2] * v0[2] + v0[3] * v0[3] + v1[0] * v1[0] + v1[1] * v1[1] + v1[2] * v1[2] + v1[3] * v1[3];
                        *(u32x4*)(cqkv + ((size_t)r * 512 + col)) = pack8(v0, v1); }
                    sq += __shfl_xor(sq, 16); sq += __shfl_xor(sq, 32);
                    if (fq == 0) atomicAdd(ssq + (size_t)(pn - 10) * T + r, sq);
                } else {
                    f32x4 v0 = acc[ai][0][m][0], v1 = acc[ai][0][m][1];
                    f32x4 o0, o1;
#pragma unroll
                    for (int e = 0; e < 4; ++e) { o0[e] = __shfl_xor(v0[e], 32); o1[e] = __shfl_xor(v1[e], 32); }
                    if (wc == 0) {
                        const int ib = 8 * (fq & 1);
                        const f32x4 c0 = *(const f32x4*)(cosT + (size_t)r * 16 + ib), c1 = *(const f32x4*)(cosT + (size_t)r * 16 + ib + 4);
                        const f32x4 s0 = *(const f32x4*)(sinT + (size_t)r * 16 + ib), s1 = *(const f32x4*)(sinT + (size_t)r * 16 + ib + 4);
                        f32x4 r0, r1;
                        if (fq < 2) { r0 = v0 * c0 - o0 * s0; r1 = v1 * c1 - o1 * s1; } else { r0 = o0 * s0 + v0 * c0; r1 = o1 * s1 + v1 * c1; }
                        *(u32x4*)(kr + ((size_t)r * 32 + 8 * fq)) = pack8(r0, r1);
                    }
                }
            }
    }
};

struct EpiB {
    bf16_t* qa; bf16_t* ka; bf16_t* vt; float* ebuf; const float* ssq; const float* cosT; const float* sinT;
    DI void operator()(const f32x4 (&acc)[2][2][4][2], const GUnit& u, int wr, int wc, int fr, int fq) const {
        if (u.tag == 0) {
#pragma unroll
            for (int ai = 0; ai < 2; ++ai)
#pragma unroll
                for (int m = 0; m < 4; ++m) {
                    const int r = EPI_ROWS(ai, m);
                    const float rs = rsqrtf(ssq[r] * (1.f / 256.f) + 1e-6f);
#pragma unroll
                    for (int bj = 0; bj < 2; ++bj) {
                        const int g32 = u.pn * 8 + bj * 4 + wc;
                        f32x4 v0 = acc[ai][bj][m][0] * rs, v1 = acc[ai][bj][m][1] * rs;
                        f32x4 o0, o1;
#pragma unroll
                        for (int e = 0; e < 4; ++e) { o0[e] = __shfl_xor(v0[e], 32); o1[e] = __shfl_xor(v1[e], 32); }
                        if (g32 % 3 == 2) {
                            const int ib = 8 * (fq & 1);
                            const f32x4 c0 = *(const f32x4*)(cosT + (size_t)r * 16 + ib), c1 = *(const f32x4*)(cosT + (size_t)r * 16 + ib + 4);
                            const f32x4 s0 = *(const f32x4*)(sinT + (size_t)r * 16 + ib), s1 = *(const f32x4*)(sinT + (size_t)r * 16 + ib + 4);
                            if (fq < 2) { v0 = v0 * c0 - o0 * s0; v1 = v1 * c1 - o1 * s1; } else { v0 = o0 * s0 + v0 * c0; v1 = o1 * s1 + v1 * c1; }
                        }
                        *(u32x4*)(qa + ((size_t)r * 768 + EPI_COL(bj))) = pack8(v0, v1);
                    }
                }
        } else if (u.tag == 1) {
#pragma unroll
            for (int ai = 0; ai < 2; ++ai)
#pragma unroll
                for (int m = 0; m < 4; ++m) {
                    const int r = EPI_ROWS(ai, m);
                    const float rs = rsqrtf(ssq[T + r] * (1.f / 256.f) + 1e-6f);
#pragma unroll
                    for (int bj = 0; bj < 2; ++bj) *(u32x4*)(ka + ((size_t)r * 512 + EPI_COL(bj))) = pack8(acc[ai][bj][m][0] * rs, acc[ai][bj][m][1] * rs);
                }
        } else if (u.tag == 2) {
#pragma unroll
            for (int bj = 0; bj < 2; ++bj) {
                const int col = EPI_COL(bj);
                f32x4 rs0, rs1;
#pragma unroll
                for (int e = 0; e < 4; ++e) { rs0[e] = rsqrtf(ssq[T + col + e] * (1.f / 256.f) + 1e-6f); rs1[e] = rsqrtf(ssq[T + col + 4 + e] * (1.f / 256.f) + 1e-6f); }
#pragma unroll
                for (int ai = 0; ai < 2; ++ai)
#pragma unroll
                    for (int m = 0; m < 4; ++m) { const int r = EPI_ROWS(ai, m);
                        *(u32x4*)(vt + ((size_t)r * VTP + col)) = pack8(acc[ai][bj][m][0] * rs0, acc[ai][bj][m][1] * rs1); }
            }
        } else {
            const int g = u.pm / 9, rt = u.pm - g * 9;
#pragma unroll
            for (int ai = 0; ai < 2; ++ai)
#pragma unroll
                for (int m = 0; m < 4; ++m) {
                    const int R = rt * 256 + ai * 128 + wr * 64 + m * 16 + fr;
                    if (R < LSEQ) { float* p = ebuf + ((size_t)(g * LSEQ + R) * 128 + wc * 32 + 8 * fq);
                        *(f32x4*)p = acc[ai][0][m][0]; *(f32x4*)(p + 4) = acc[ai][0][m][1]; }
                }
        }
    }
};
struct SchedB {
    const char* A; const char* B; int lda, ldb, nt, tag, G, c;
    DI bool next(int i, GUnit& u) const {
        const int L = i * G + c; u.tag = tag;
        if (tag == 0) { if (L >= 387) return false; u.pm = L / 3; u.pn = L % 3; u.a = A + (size_t)u.pm * 256 * 512 * 2; u.b = B + (size_t)u.pn * 256 * 256 * 2; return true; }
        if (L >= 258) return false;
        if (tag == 1) { u.pm = L / 2; u.pn = L % 2; u.a = A + (size_t)u.pm * 256 * 512 * 2; u.b = B + (size_t)u.pn * 256 * 256 * 2; return true; }
        u.pm = L % 2; u.pn = L / 2; u.a = A + (size_t)u.pm * 256 * 256 * 2; u.b = B + (size_t)u.pn * 256 * 512 * 2; return true;
    }
};

struct EpiS5Y {
    bf16_t* yg;
    DI void operator()(const f32x4 (&acc)[2][2][4][2], const GUnit& u, int wr, int wc, int fr, int fq) const {
        const int g = u.pm / 9, rt = u.pm - g * 9;
#pragma unroll
        for (int ai = 0; ai < 2; ++ai)
#pragma unroll
            for (int m = 0; m < 4; ++m) {
                const int R = rt * 256 + ai * 128 + wr * 64 + m * 16 + fr;
                if (R < LSEQ) {
                    const int b = R / NCHK, chunk = R - b * NCHK;
#pragma unroll
                    for (int bj = 0; bj < 2; ++bj) {
                        const int col = bj * 128 + wc * 32 + 8 * fq, t = col >> 4, co = col & 15;
                        f32x4 v0 = acc[ai][bj][m][0], v1 = acc[ai][bj][m][1];
#pragma unroll
                        for (int e = 0; e < 4; ++e) { v0[e] = gelu_tanh(v0[e]); v1[e] = gelu_tanh(v1[e]); }
                        *(u32x4*)(yg + ((size_t)(b * LSEQ + chunk * 16 + t) * 512 + g * 16 + co)) = pack8(v0, v1);
                    }
                }
            }
    }
};
struct SchedS5 {
    const char* ug; const char* mat; int lda, ldb, nt, tag, G, c;
    DI bool next(int i, GUnit& u) const {
        const int L = i * G + c; if (L >= 288) return false;
        const int g = L / 9, rt = L - g * 9; u.tag = tag; u.pm = L; u.pn = 0;
        u.a = ug + ((size_t)g * SROWS + rt * 256) * 384 * 2; u.b = mat + (size_t)g * 256 * ldb * 2; return true;
    }
};

struct EpiGlu {
    const bf16_t* yg; bf16_t* out;
    DI void operator()(const f32x4 (&acc)[2][2][4][2], const GUnit& u, int wr, int wc, int fr, int fq) const {
#pragma unroll
        for (int ai = 0; ai < 2; ++ai)
#pragma unroll
            for (int m = 0; m < 4; ++m) { const int r = EPI_ROWS(ai, m);
#pragma unroll
                for (int bj = 0; bj < 2; ++bj) { const size_t off = (size_t)r * 512 + EPI_COL(bj);
                    const u32x4 y = *(const u32x4*)(yg + off); const f32x4 a0 = acc[ai][bj][m][0], a1 = acc[ai][bj][m][1];
                    f32x4 v0, v1;
                    v0[0] = bflo(y.x) * sigm(a0[0]); v0[1] = bfhi(y.x) * sigm(a0[1]); v0[2] = bflo(y.y) * sigm(a0[2]); v0[3] = bfhi(y.y) * sigm(a0[3]);
                    v1[0] = bflo(y.z) * sigm(a1[0]); v1[1] = bfhi(y.z) * sigm(a1[1]); v1[2] = bflo(y.w) * sigm(a1[2]); v1[3] = bfhi(y.w) * sigm(a1[3]);
                    *(u32x4*)(out + off) = pack8(v0, v1); } }
    }
};

struct EpiF {
    bf16_t* gateb; bf16_t* mixed; const float* st; const float* cs; const float* bw; unsigned* flags; unsigned base;
    DI void operator()(const f32x4 (&acc)[2][2][4][2], const GUnit& u, int wr, int wc, int fr, int fq) const {
        const int j = u.tag & 7; const bool tail = (u.tag & 8) != 0;
        if (tail && j > 0) {
            unsigned* f = flags + 64 * u.pn; const unsigned need = base + 8u * (unsigned)j; unsigned sp = 0;
            while (__hip_atomic_load(f, __ATOMIC_RELAXED, __HIP_MEMORY_SCOPE_AGENT) < need && ++sp < (1u << 22)) __builtin_amdgcn_s_sleep(1);
            __builtin_amdgcn_fence(__ATOMIC_ACQUIRE, "agent");
        }
        CV4 cvv[2]; if (st && (j & 1) == 0) { cvv[0] = cv_load(cs, bw, (j >> 1) * 1024 + EPI_COL(0)); cvv[1] = cv_load(cs, bw, (j >> 1) * 1024 + EPI_COL(1)); }
#pragma unroll
        for (int ai = 0; ai < 2; ++ai)
#pragma unroll
            for (int m = 0; m < 4; ++m) { const int r = EPI_ROWS(ai, m);
                float mu = 0.f, rs = 1.f; if (st && (j & 1) == 0) ln_stats(st, r, mu, rs);
#pragma unroll
                for (int bj = 0; bj < 2; ++bj) { const size_t off = (size_t)r * 1024 + EPI_COL(bj);
                    f32x4 a0 = acc[ai][bj][m][0], a1 = acc[ai][bj][m][1];
                    if ((j & 1) == 0) {
                        if (st) ln_fix2(a0, a1, mu, rs, cvv[bj]);
#pragma unroll
                        for (int e = 0; e < 4; ++e) { a0[e] = sigm(a0[e]); a1[e] = sigm(a1[e]); }
                        *(u32x4*)(gateb + off) = pack8(a0, a1);
                    } else {
                        const u32x4 gt = *(const u32x4*)(gateb + off);
                        a0[0] *= bflo(gt.x); a0[1] *= bfhi(gt.x); a0[2] *= bflo(gt.y); a0[3] *= bfhi(gt.y);
                        a1[0] *= bflo(gt.z); a1[1] *= bfhi(gt.z); a1[2] *= bflo(gt.w); a1[3] *= bfhi(gt.w);
                        if (j > 1) { const u32x4 mx = *(const u32x4*)(mixed + off);
                            a0[0] += bflo(mx.x); a0[1] += bfhi(mx.x); a0[2] += bflo(mx.y); a0[3] += bfhi(mx.y);
                            a1[0] += bflo(mx.z); a1[1] += bfhi(mx.z); a1[2] += bflo(mx.w); a1[3] += bfhi(mx.w); }
                        *(u32x4*)(mixed + off) = pack8(a0, a1);
                    } } }
        if (tail) { asm volatile("s_waitcnt vmcnt(0)" ::: "memory"); __builtin_amdgcn_fence(__ATOMIC_RELEASE, "agent"); asm volatile("s_waitcnt vmcnt(0)" ::: "memory");
            if ((otid() & 63) == 0) __hip_atomic_fetch_add(flags + 64 * u.pn, 1u, __ATOMIC_RELAXED, __HIP_MEMORY_SCOPE_AGENT); }
    }
};
struct SchedF {
    const char* A; const char* B; int lda, ldb, nt, j, G, c;
    DI bool next(int i, GUnit& u) const {
        int tI = i * G + c; u.tag = j;
        if (tI >= 512) { const int t = c - 4 * j; if (i * G >= 512 + G || t < 0 || t >= 4 || (i > 0 && (i - 1) * G + c >= 512)) return false; tI = 512 + t; u.tag = j | 8; }
        u.pm = tI >> 2; u.pn = tI & 3;
        u.a = A + (size_t)u.pm * 256 * lda * 2; u.b = B + (size_t)u.pn * 256 * ldb * 2; return true;
    }
};

struct EpiRes {
    bf16_t* hbf; const float* st_in; const float* g_in; const float* b_in; float* st_out;
    DI void operator()(const f32x4 (&acc)[2][2][4][2], const GUnit& u, int wr, int wc, int fr, int fq) const {
        CV4 gb[2]; if (st_in) { gb[0] = cv_load(g_in, b_in, EPI_COL(0)); gb[1] = cv_load(g_in, b_in, EPI_COL(1)); }
#pragma unroll
        for (int ai = 0; ai < 2; ++ai)
#pragma unroll
            for (int m = 0; m < 4; ++m) { const int r = EPI_ROWS(ai, m);
                float mu = 0.f, rs = 1.f; if (st_in) ln_stats(st_in, r, mu, rs);
                float a1 = 0.f, a2 = 0.f;
#pragma unroll
                for (int bj = 0; bj < 2; ++bj) { const int col = EPI_COL(bj); bf16_t* pb = hbf + (size_t)r * 1024 + col;
                    const u32x4 hw = *(const u32x4*)pb;
                    f32x4 h0 = {bflo(hw.x), bfhi(hw.x), bflo(hw.y), bfhi(hw.y)}, h1 = {bflo(hw.z), bfhi(hw.z), bflo(hw.w), bfhi(hw.w)};
                    if (st_in) { h0 = (h0 - mu) * rs * gb[bj].c0 + gb[bj].b0; h1 = (h1 - mu) * rs * gb[bj].c1 + gb[bj].b1; }
                    const f32x4 r0 = h0 * ALPHA + acc[ai][bj][m][0], r1 = h1 * ALPHA + acc[ai][bj][m][1];
                    *(u32x4*)pb = pack8(r0, r1);
                    a1 += (r0[0] + r0[1]) + (r0[2] + r0[3]) + (r1[0] + r1[1]) + (r1[2] + r1[3]);
                    a2 += (r0[0] * r0[0] + r0[1] * r0[1]) + (r0[2] * r0[2] + r0[3] * r0[3]) + (r1[0] * r1[0] + r1[1] * r1[1]) + (r1[2] * r1[2] + r1[3] * r1[3]); }
                a1 += __shfl_xor(a1, 16); a1 += __shfl_xor(a1, 32); a2 += __shfl_xor(a2, 16); a2 += __shfl_xor(a2, 32);
                if (fq == 0) { atomicAdd(st_out + (size_t)r * 2, a1); atomicAdd(st_out + (size_t)r * 2 + 1, a2); } }
    }
};
struct EpiFfn1 {
    bf16_t* hff; const float* st; const float* cs; const float* bw;
    DI void operator()(const f32x4 (&acc)[2][2][4][2], const GUnit& u, int wr, int wc, int fr, int fq) const {
        const CV4 cvg = cv_load(cs, bw, EPI_COL(0)), cvu = cv_load(cs, bw, EPI_COL(1));
#pragma unroll
        for (int ai = 0; ai < 2; ++ai)
#pragma unroll
            for (int m = 0; m < 4; ++m) { const int r = EPI_ROWS(ai, m);
                f32x4 v0, v1; f32x4 g0 = acc[ai][0][m][0], g1 = acc[ai][0][m][1], u0 = acc[ai][1][m][0], u1 = acc[ai][1][m][1];
                { float mu, rs; ln_stats(st, r, mu, rs); ln_fix2(g0, g1, mu, rs, cvg); ln_fix2(u0, u1, mu, rs, cvu); }
#pragma unroll
                for (int e = 0; e < 4; ++e) { v0[e] = g0[e] * sigm(g0[e]) * u0[e]; v1[e] = g1[e] * sigm(g1[e]) * u1[e]; }
                *(u32x4*)(hff + ((size_t)r * DFF + u.pn * 128 + wc * 32 + 8 * fq)) = pack8(v0, v1); }
    }
};

template <class F> DI void tconv(bf16_t* dst, int N, int K, int gtid_, int gthreads, F f) {
    const int gtid = blockIdx.x * 512 + otid(); gthreads = ogrid() * 512;
    const int kb8 = K / 8; const long total = (long)N * kb8;
    for (long idx = gtid; idx < total; idx += gthreads) {
        const int n = (int)(idx % N), kb = (int)(idx / N);
        float v[8];
#pragma unroll
        for (int i = 0; i < 8; ++i) v[i] = f(n, kb * 8 + i);
        u32x4 w; w.x = pk2(v[0], v[1]); w.y = pk2(v[2], v[3]); w.z = pk2(v[4], v[5]); w.w = pk2(v[6], v[7]);
        *(u32x4*)(dst + ((size_t)n * K + kb * 8)) = w;
    }
}

template <class F> DI void colvec(float* cs, float* bw, int N, int K, const float* g, const float* b, LAS unsigned char* lds, F f) {
    LAS float* red = (LAS float*)lds;
    const int tid = otid(), nn = tid & 31, ks = tid >> 5, G = ogrid(), kper = K >> 4;
    for (int task = blockIdx.x; task * 32 < N; task += G) {
        const int n = task * 32 + nn; float a = 0.f, c = 0.f;
#pragma unroll 8
        for (int kk = 0; kk < kper; ++kk) { const int k = ks * kper + kk; const float w = f(n, k); a += bflo(pk2(w * g[k], 0.f)); c += b[k] * w; }
        __syncthreads();
        red[(ks * 32 + nn) * 2] = a; red[(ks * 32 + nn) * 2 + 1] = c;
        __syncthreads();
        if (tid < 32) { float sa = 0.f, sc = 0.f;
#pragma unroll
            for (int j = 0; j < 16; ++j) { sa += red[(j * 32 + tid) * 2]; sc += red[(j * 32 + tid) * 2 + 1]; }
            cs[task * 32 + tid] = sa; bw[task * 32 + tid] = sc; }
    }
    __syncthreads();
}
DI void convert_weights(KP p, int l, int part, LAS unsigned char* lds) {
    const int gtid = 0, gthreads = 0;
    p = kp_launder(p);
    unsigned char* ws = p->ws; float* cv = (float*)(ws + O_COLV);
    if (part == 0) {
    { const float* w = (const float*)p->in[5] + (size_t)l * 1024 * 6176; const float* g2 = (const float*)p->in[30] + (l - 1) * 1024; const float* b2 = (const float*)p->in[31] + (l - 1) * 1024; const bool fold = l > 0;
      auto fin = [=](int n, int k) -> float { const int src = n < 512 ? 544 + n : (n < 2560 ? 1056 + (n - 512) : (n < 3104 ? n - 2560 : -1)); return src < 0 ? 0.f : w[(size_t)k * 6176 + src]; };
      auto fgate = [=](int n, int k) -> float { return w[(size_t)k * 6176 + 3104 + n]; };
      tconv((bf16_t*)(ws + W_WIN), 3328, 1024, gtid, gthreads, [=](int n, int k) -> float { const float v = fin(n, k); return fold ? v * g2[k] : v; });
      tconv((bf16_t*)(ws + W_WGATE), 3072, 1024, gtid, gthreads, [=](int n, int k) -> float { const float v = fgate(n, k); return fold ? v * g2[k] : v; });
      if (fold) { colvec(cv + CV_IN, cv + CV_IN + 3328, 3328, 1024, g2, b2, lds, fin); colvec(cv + CV_GATE, cv + CV_GATE + 3072, 3072, 1024, g2, b2, lds, fgate); } }
    { const float* w = (const float*)p->in[7] + (size_t)l * 256 * 768; const float* g = (const float*)p->in[6] + l * 256;
      tconv((bf16_t*)(ws + W_WUQ), 768, 256, gtid, gthreads, [=](int n, int k) -> float { return w[(size_t)k * 768 + n] * g[k] * QSCALE; }); }
    { const float* w = (const float*)p->in[9] + (size_t)l * 256 * 1024; const float* g = (const float*)p->in[8] + l * 256;
      tconv((bf16_t*)(ws + W_WK), 512, 256, gtid, gthreads, [=](int n, int k) -> float { return w[(size_t)k * 1024 + (n >> 6) * 128 + (n & 63)] * g[k]; });
      tconv((bf16_t*)(ws + W_WV), 512, 256, gtid, gthreads, [=](int n, int k) -> float { return w[(size_t)k * 1024 + (n >> 6) * 128 + 64 + (n & 63)] * g[k]; }); }
    { const float* w = (const float*)p->in[18] + (size_t)l * 512 * 512;
      tconv((bf16_t*)(ws + W_WGLU), 512, 512, gtid, gthreads, [=](int n, int k) -> float { return w[(size_t)k * 512 + n]; }); }
#pragma unroll
    for (int br = 0; br < 3; ++br) { const float* w = (const float*)p->in[21 + br] + (size_t)l * 512 * 1024;
      tconv((bf16_t*)(ws + W_WBR) + (size_t)br * 1024 * 512, 1024, 512, gtid, gthreads, [=](int n, int k) -> float { return w[(size_t)k * 1024 + n]; }); }
    { const float* w = (const float*)p->in[24] + (size_t)l * 1024 * 1024;
      tconv((bf16_t*)(ws + W_WOUT), 1024, 1024, gtid, gthreads, [=](int n, int k) -> float { return w[(size_t)k * 1024 + n]; }); }
    } else {
    { const float* wg = (const float*)p->in[27] + (size_t)l * 1024 * DFF; const float* wu = (const float*)p->in[28] + (size_t)l * 1024 * DFF; const float* g1 = (const float*)p->in[25] + l * 1024; const float* b1 = (const float*)p->in[26] + l * 1024;
      auto fgu = [=](int n, int k) -> float { const int pn = n >> 8, r = n & 255; return r < 128 ? wg[(size_t)k * DFF + pn * 128 + r] : wu[(size_t)k * DFF + pn * 128 + r - 128]; };
      tconv((bf16_t*)(ws + W_WGU), 5632, 1024, gtid, gthreads, [=](int n, int k) -> float { return fgu(n, k) * g1[k]; });
      colvec(cv + CV_GU, cv + CV_GU + 5632, 5632, 1024, g1, b1, lds, fgu); }
    { const float* w = (const float*)p->in[29] + (size_t)l * DFF * 1024;
      tconv((bf16_t*)(ws + W_WD), 1024, DFF, gtid, gthreads, [=](int n, int k) -> float { return w[(size_t)k * 1024 + n]; }); }
    }
}

DI void s5_build(KP p, int l, LAS unsigned char* lds) {
    p = kp_launder(p);
    LAS float* PT = (LAS float*)lds;
    LAS float* BB = PT + 64 * 17 * 2;
    LAS float* KT = BB + 64 * 16 * 2;
    const int tid = otid(), G = ogrid();
    for (int job = blockIdx.x; job < 256; job += G) {
        const int g = job >> 3, part = job & 7;
        const float* lam_re = (const float*)p->in[10] + (size_t)(l * 32 + g) * 64;
        const float* lam_im = (const float*)p->in[11] + (size_t)(l * 32 + g) * 64;
        const float dt = expf(((const float*)p->in[12])[l * 32 + g]);
        const float* b_re = (const float*)p->in[13] + (size_t)(l * 32 + g) * 64 * 16;
        const float* b_im = (const float*)p->in[14] + (size_t)(l * 32 + g) * 64 * 16;
        const float* c_re = (const float*)p->in[15] + (size_t)(l * 32 + g) * 16 * 64;
        const float* c_im = (const float*)p->in[16] + (size_t)(l * 32 + g) * 16 * 64;
        const float* dsk = (const float*)p->in[17] + (size_t)l * 512 + g * 16;
        __syncthreads();
        for (int idx = tid; idx < 64 * 17; idx += 512) {
            const int n = idx / 17, tau = idx - n * 17;
            const float lr = fminf(lam_re[n], -1e-4f), li = lam_im[n];
            const float mag = expf(lr * dt * (float)tau); float sn, cn; sincosf(li * dt * (float)tau, &sn, &cn);
            PT[idx * 2] = mag * cn; PT[idx * 2 + 1] = mag * sn;
        }
        for (int idx = tid; idx < 64 * 16; idx += 512) {
            const int n = idx >> 4;
            const float lr = fminf(lam_re[n], -1e-4f), li = lam_im[n];
            const float mag = expf(lr * dt); float sn, cn; sincosf(li * dt, &sn, &cn);
            const float abr = mag * cn, abi = mag * sn, den = lr * lr + li * li, nr = abr - 1.f;
            const float cr = (nr * lr + abi * li) / den, ci = (abi * lr - nr * li) / den;
            const float br = b_re[idx], bi = b_im[idx];
            BB[idx * 2] = cr * br - ci * bi; BB[idx * 2 + 1] = cr * bi + ci * br;
        }
        __syncthreads();
        { const int tau = tid >> 5, coi = (tid >> 4) & 1, ci = tid & 15, co = 2 * part + coi;
          float acc = 0.f;
#pragma unroll 8
          for (int n = 0; n < 64; ++n) {
              const float pr = PT[(n * 17 + tau) * 2], pi = PT[(n * 17 + tau) * 2 + 1], br = BB[(n * 16 + ci) * 2], bi = BB[(n * 16 + ci) * 2 + 1];
              const float xr = pr * br - pi * bi, xi = pr * bi + pi * br;
              acc += c_re[co * 64 + n] * xr - c_im[co * 64 + n] * xi;
          }
          KT[tid] = acc; }
        __syncthreads();
        bf16_t* mb = (bf16_t*)(p->ws + W_MB) + (size_t)g * 256 * 256;
        bf16_t* md = (bf16_t*)(p->ws + W_MD) + (size_t)g * 256 * 384;
        for (int idx = tid; idx < 32 * 256; idx += 512) {
            const int col = 32 * part + (idx >> 8), k = idx & 255, sx = k >> 4, cx = k & 15; float v = 0.f;
            if (col < 128) { const int n = col & 63; const float pr = PT[(n * 17 + 15 - sx) * 2], pi = PT[(n * 17 + 15 - sx) * 2 + 1], br = BB[(n * 16 + cx) * 2], bi = BB[(n * 16 + cx) * 2 + 1];
                v = col < 64 ? pr * br - pi * bi : pr * bi + pi * br; }
            mb[(size_t)col * 256 + k] = f2bf(v);
        }
        for (int idx = tid; idx < 32 * 384; idx += 512) {
            const int rr = idx / 384, k = idx - rr * 384, t = rr >> 1, coi = rr & 1, co = 2 * part + coi; float v;
            if (k < 256) { const int sx = k >> 4, ci = k & 15; v = sx <= t ? KT[((t - sx) * 2 + coi) * 16 + ci] : 0.f; if (sx == t && ci == co) v += dsk[co]; }
            else { const int n = (k - 256) & 63; const float pr = PT[(n * 17 + t + 1) * 2], pi = PT[(n * 17 + t + 1) * 2 + 1], cr = c_re[co * 64 + n], ci = c_im[co * 64 + n];
                v = k < 320 ? cr * pr - ci * pi : -(cr * pi + ci * pr); }
            md[(size_t)(t * 16 + co) * 384 + k] = f2bf(v);
        }
        if (part == 0 && tid < 64) { float* a16 = (float*)(p->ws + W_A16) + (size_t)g * 128; a16[tid * 2] = PT[(tid * 17 + 16) * 2]; a16[tid * 2 + 1] = PT[(tid * 17 + 16) * 2 + 1]; }
    }
    __syncthreads();
}

DI void ln_rows(KP p, int mode, const float* gam, const float* bet, int gwave_, int nwaves, int lane_) {
    p = kp_launder(p);
    const int tid_ = otid(), lane = tid_ & 63, gwave = blockIdx.x * 8 + __builtin_amdgcn_readfirstlane(tid_ >> 6); nwaves = ogrid() * 8;
    bf16_t* hbf = (bf16_t*)(p->ws + O_HBF);
    for (int r = gwave; r < T; r += nwaves) {
        const int b = r / LSEQ, tt = r - b * LSEQ;
        if (mode == 2 && tt < 16) continue;
        f32x4 v[4]; float s = 0.f;
        if (mode == 0) { const float* src = tt < 16 ? (const float*)p->in[2] + (size_t)tt * 1024 : (const float*)p->in[0] + ((size_t)b * 2048 + tt - 16) * 1024;
#pragma unroll
            for (int i = 0; i < 4; ++i) v[i] = *(const f32x4*)(src + i * 256 + lane * 4);
        } else {
#pragma unroll
            for (int i = 0; i < 4; ++i) { const u32x2 w = *(const u32x2*)(hbf + (size_t)r * 1024 + i * 256 + lane * 4); v[i] = (f32x4){bflo(w.x), bfhi(w.x), bflo(w.y), bfhi(w.y)}; }
        }
#pragma unroll
        for (int i = 0; i < 4; ++i) s += v[i][0] + v[i][1] + v[i][2] + v[i][3];
#pragma unroll
        for (int o = 1; o < 64; o <<= 1) s += __shfl_xor(s, o);
        const float mu = s * (1.f / 1024.f); float q = 0.f;
#pragma unroll
        for (int i = 0; i < 4; ++i) { const f32x4 d = v[i] - mu; q += d[0] * d[0] + d[1] * d[1] + d[2] * d[2] + d[3] * d[3]; }
#pragma unroll
        for (int o = 1; o < 64; o <<= 1) q += __shfl_xor(q, o);
        const float rstd = rsqrtf(q * (1.f / 1024.f) + 1e-5f);
#pragma unroll
        for (int i = 0; i < 4; ++i) {
            const int c = i * 256 + lane * 4;
            const f32x4 o = (v[i] - mu) * rstd * *(const f32x4*)(gam + c) + *(const f32x4*)(bet + c);
            if (mode == 2) *(f32x4*)(p->out + ((size_t)b * 2048 + tt - 16) * 1024 + c) = o;
            else { u32x2 w; w.x = pk2(o[0], o[1]); w.y = pk2(o[2], o[3]); *(u32x2*)(hbf + (size_t)r * 1024 + c) = w; }
        }
    }
}

constexpr int AT_KP = 104, AT_VP = 36, AT_BUF = 32 * AT_KP * 2 + 64 * AT_VP * 2;
DI void attn_softmax_pv(f32x16& S, f32x16& O0, f32x16& O1, float& mrun, float& lsum, const bf16x8 (&vf)[2][2]) {
    float mx = S[0];
#pragma unroll
    for (int r = 1; r < 16; ++r) mx = fmaxf(mx, S[r]);
    mx = fmaxf(mx, __shfl_xor(mx, 32));
    const float mnew = fmaxf(mrun, mx);
    float ps = 0.f;
#pragma unroll
    for (int r = 0; r < 16; ++r) { S[r] = __builtin_amdgcn_exp2f(S[r] - mnew); ps += S[r]; }
    if (__builtin_amdgcn_ballot_w64(mnew > mrun) != 0ull) {
        const float alpha = __builtin_amdgcn_exp2f(mrun - mnew);
        lsum *= alpha;
#pragma unroll
        for (int i = 0; i < 16; ++i) { O0[i] *= alpha; O1[i] *= alpha; }
    }
    mrun = mnew; lsum += ps;
#pragma unroll
    for (int kk = 0; kk < 2; ++kk) {
        u32x4 w; w.x = pk2(S[8 * kk], S[8 * kk + 1]); w.y = pk2(S[8 * kk + 2], S[8 * kk + 3]); w.z = pk2(S[8 * kk + 4], S[8 * kk + 5]); w.w = pk2(S[8 * kk + 6], S[8 * kk + 7]);
        const bf16x8 pf = __builtin_bit_cast(bf16x8, w);
        O0 = __builtin_amdgcn_mfma_f32_32x32x16_bf16(vf[0][kk], pf, O0, 0, 0, 0);
        O1 = __builtin_amdgcn_mfma_f32_32x32x16_bf16(vf[1][kk], pf, O1, 0, 0, 0);
    }
}
DI void attn_store(bf16_t* oo, size_t tokq, int h, int half, const f32x16& O0, const f32x16& O1, float inv) {
#pragma unroll
    for (int blk = 0; blk < 4; ++blk) {
        u32x2 w0, w1;
        w0.x = pk2(O0[4 * blk] * inv, O0[4 * blk + 1] * inv); w0.y = pk2(O0[4 * blk + 2] * inv, O0[4 * blk + 3] * inv);
        w1.x = pk2(O1[4 * blk] * inv, O1[4 * blk + 1] * inv); w1.y = pk2(O1[4 * blk + 2] * inv, O1[4 * blk + 3] * inv);
        *(u32x2*)(oo + tokq * 512 + h * 64 + 8 * blk + 4 * half) = w0;
        *(u32x2*)(oo + tokq * 512 + h * 64 + 32 + 8 * blk + 4 * half) = w1;
    }
}
DI void attention_phase(KP p, LAS unsigned char* lds) {
    p = kp_launder(p);
    const int tid = otid(), lane = tid & 63, wid = __builtin_amdgcn_readfirstlane(tid >> 6);
    const bf16_t* qa = (const bf16_t*)((unsigned char*)p->out + X_QA);
    const bf16_t* ka = (const bf16_t*)(p->ws + O_KA); const bf16_t* kr = (const bf16_t*)(p->ws + O_KR); const bf16_t* vt = (const bf16_t*)(p->ws + O_VT);
    bf16_t* oo = (bf16_t*)(p->ws + O_O);
    const int G = ogrid(), l31 = lane & 31, half = lane >> 5;
    const bool c0k = tid < 384; const int c0 = c0k ? tid : tid - 384, c1 = tid + 128;
    for (int it = 0; it * G < 1024; ++it) {
        const int u = it * G + blockIdx.x;
        if (u >= 1024) break;
        const int bh = u & 127, pp = u >> 7, b = bh >> 3, h = bh & 7;
        const int j = (0x46315720 >> (4 * pp)) & 7;
        const int ktmax = 8 * j + 8, dkt = 8 * j + wid + 1;
        const size_t tok0 = (size_t)b * LSEQ;
        const size_t tokq = tok0 + 16 + 256 * j + 32 * wid + l31;
        bf16x8 qf[6];
#pragma unroll
        for (int ks = 0; ks < 6; ++ks) qf[ks] = *(const bf16x8*)(qa + tokq * 768 + h * 96 + ks * 16 + half * 8);
        f32x16 O0, O1;
#pragma unroll
        for (int i = 0; i < 16; ++i) { O0[i] = 0.f; O1[i] = 0.f; }
        float mrun = -1e30f, lsum = 0.f;
        u32x4 sa[3], sb[3];
#pragma unroll
        for (int i = 0; i < 3; ++i) { sa[i] = (u32x4){0u, 0u, 0u, 0u}; sb[i] = (u32x4){0u, 0u, 0u, 0u}; }
#define AT_GLOAD(kt, slot) do { const int k0_ = (kt) == 0 ? 0 : 16 + 32 * ((kt) - 1); \
            if (c0k) { const int key = c0 / 12, part = c0 - key * 12; const size_t tok = tok0 + k0_ + key; \
                sa[slot] = part < 8 ? *(const u32x4*)(ka + tok * 512 + h * 64 + 8 * part) : *(const u32x4*)(kr + tok * 32 + 8 * (part - 8)); } \
            else { const int dv = c0 >> 2, part = c0 & 3; sa[slot] = *(const u32x4*)(vt + (size_t)(h * 64 + dv) * VTP + tok0 + k0_ + 8 * part); } \
            if (tid < 128) { const int dv = c1 >> 2, part = c1 & 3; sb[slot] = *(const u32x4*)(vt + (size_t)(h * 64 + dv) * VTP + tok0 + k0_ + 8 * part); } } while (0)
#define AT_LSTORE(buf, slot) do { LAS unsigned char* B_ = lds + (buf) * AT_BUF; \
            if (c0k) { const int key = c0 / 12, part = c0 - key * 12; *(LAS u32x4*)(B_ + key * (AT_KP * 2) + part * 16) = sa[slot]; } \
            else { const int dv = c0 >> 2, part = c0 & 3; LAS unsigned char* d = B_ + 32 * AT_KP * 2 + dv * (AT_VP * 2) + part * 16; *(LAS u32x2*)d = (u32x2){sa[slot].x, sa[slot].y}; *(LAS u32x2*)(d + 8) = (u32x2){sa[slot].z, sa[slot].w}; } \
            if (tid < 128) { const int dv = c1 >> 2, part = c1 & 3; LAS unsigned char* d = B_ + 32 * AT_KP * 2 + dv * (AT_VP * 2) + part * 16; *(LAS u32x2*)d = (u32x2){sb[slot].x, sb[slot].y}; *(LAS u32x2*)(d + 8) = (u32x2){sb[slot].z, sb[slot].w}; } } while (0)
#define AT_STEP(kt, slot) do { \
            if ((kt) + 3 <= ktmax) AT_GLOAD((kt) + 3, slot); \
            if ((kt) <= dkt) { \
                const LAS unsigned char* B = lds + ((kt) & 1) * AT_BUF; \
                f32x16 S; \
                _Pragma("unroll") for (int i = 0; i < 16; ++i) S[i] = 0.f; \
                _Pragma("unroll") for (int ks = 0; ks < 6; ++ks) { const bf16x8 kf = *(const LAS bf16x8*)(B + l31 * (AT_KP * 2) + ks * 32 + half * 16); S = __builtin_amdgcn_mfma_f32_32x32x16_bf16(kf, qf[ks], S, 0, 0, 0); } \
                bf16x8 vf[2][2]; \
                _Pragma("unroll") for (int rb = 0; rb < 2; ++rb) _Pragma("unroll") for (int kk = 0; kk < 2; ++kk) { const LAS unsigned char* vp = B + 32 * AT_KP * 2 + (rb * 32 + l31) * (AT_VP * 2) + (kk * 16 + half * 4) * 2; \
                        const u32x2 lo = *(const LAS u32x2*)vp, hi = *(const LAS u32x2*)(vp + 16); u32x4 w; w.x = lo.x; w.y = lo.y; w.z = hi.x; w.w = hi.y; vf[rb][kk] = __builtin_bit_cast(bf16x8, w); } \
                if ((kt) == 0) { _Pragma("unroll") for (int r = 8; r < 16; ++r) S[r] = -1e30f; } \
                if ((kt) == dkt) { _Pragma("unroll") for (int r = 0; r < 16; ++r) { const int kl = 8 * (r >> 2) + 4 * half + (r & 3); if (kl > l31) S[r] = -1e30f; } } \
                attn_softmax_pv(S, O0, O1, mrun, lsum, vf); \
            } \
            if ((kt) < ktmax) AT_LSTORE(((kt) + 1) & 1, ((slot) + 1) % 3); \
            __syncthreads(); } while (0)
        __syncthreads();
        AT_GLOAD(0, 0); AT_GLOAD(1, 1); AT_GLOAD(2, 2);
        AT_LSTORE(0, 0);
        __syncthreads();
        for (int kt = 0; kt <= ktmax; kt += 3) {
            AT_STEP(kt, 0);
            if (kt + 1 <= ktmax) AT_STEP(kt + 1, 1);
            if (kt + 2 <= ktmax) AT_STEP(kt + 2, 2);
        }
#undef AT_GLOAD
#undef AT_LSTORE
#undef AT_STEP
        const float ltot = lsum + __shfl_xor(lsum, 32);
        attn_store(oo, tokq, h, half, O0, O1, 1.f / ltot);
    }
    {
        const int wg = blockIdx.x * 8 + wid;
        if (wg < 128) {
            const int b = wg >> 3, h = wg & 7; const size_t tokq = (size_t)b * LSEQ + l31;
            bf16x8 qf[6], kf[6], vf[2][2];
#pragma unroll
            for (int ks = 0; ks < 6; ++ks) qf[ks] = *(const bf16x8*)(qa + tokq * 768 + h * 96 + ks * 16 + half * 8);
#pragma unroll
            for (int ks = 0; ks < 4; ++ks) kf[ks] = *(const bf16x8*)(ka + tokq * 512 + h * 64 + ks * 16 + half * 8);
#pragma unroll
            for (int ks = 0; ks < 2; ++ks) kf[4 + ks] = *(const bf16x8*)(kr + tokq * 32 + ks * 16 + half * 8);
#pragma unroll
            for (int rb = 0; rb < 2; ++rb)
#pragma unroll
                for (int kk = 0; kk < 2; ++kk) { const bf16_t* vp = vt + (size_t)(h * 64 + rb * 32 + l31) * VTP + (size_t)b * LSEQ + kk * 16 + half * 4;
                    const u32x2 lo = *(const u32x2*)vp, hi = *(const u32x2*)(vp + 8); u32x4 w; w.x = lo.x; w.y = lo.y; w.z = hi.x; w.w = hi.y; vf[rb][kk] = __builtin_bit_cast(bf16x8, w); }
            f32x16 S, O0, O1;
#pragma unroll
            for (int i = 0; i < 16; ++i) { S[i] = 0.f; O0[i] = 0.f; O1[i] = 0.f; }
#pragma unroll
            for (int ks = 0; ks < 6; ++ks) S = __builtin_amdgcn_mfma_f32_32x32x16_bf16(kf[ks], qf[ks], S, 0, 0, 0);
#pragma unroll
            for (int r = 0; r < 16; ++r) { const int kl = 8 * (r >> 2) + 4 * half + (r & 3); if (kl > l31) S[r] = -1e30f; }
            float mrun = -1e30f, lsum = 0.f;
            attn_softmax_pv(S, O0, O1, mrun, lsum, vf);
            const float ltot = lsum + __shfl_xor(lsum, 32);
            if (l31 < 16) attn_store(oo, tokq, h, half, O0, O1, 1.f / ltot);
        }
    }
    __syncthreads();
}

DI void s5_scan(KP p, int gtid_, int gthreads) {
    p = kp_launder(p);
    const int gtid = blockIdx.x * 128 + otid(); gthreads = ogrid() * 128;
    const float* __restrict__ ebuf = (const float*)(p->ws + O_EBUF); const float* a16 = (const float*)(p->ws + W_A16);
    bf16_t* __restrict__ ug = (bf16_t*)((unsigned char*)p->out + X_UG);
    for (int idx = gtid; idx < 32768; idx += gthreads) {
        const int n = idx & 63, b = (idx >> 6) & 15, g = idx >> 10;
        const float ar = a16[(g * 64 + n) * 2], ai = a16[(g * 64 + n) * 2 + 1];
        float xr = 0.f, xi = 0.f;
        const float* e = ebuf + ((size_t)g * LSEQ + b * NCHK) * 128 + n;
        bf16_t* x = ug + ((size_t)g * SROWS + b * NCHK) * 384 + 256 + n;
        float er[8], ei[8], fr_[8], fi_[8];
#pragma unroll
        for (int i = 0; i < 8; ++i) { er[i] = e[(size_t)i * 128]; ei[i] = e[(size_t)i * 128 + 64]; }
        for (int ch0 = 0; ch0 < NCHK; ch0 += 8) {
#pragma unroll
            for (int i = 0; i < 8; ++i) { const int ch = ch0 + 8 + i; const bool ok = ch < NCHK; fr_[i] = ok ? e[(size_t)ch * 128] : 0.f; fi_[i] = ok ? e[(size_t)ch * 128 + 64] : 0.f; }
#pragma unroll
            for (int i = 0; i < 8; ++i) { const int ch = ch0 + i;
                if (ch < NCHK) { x[(size_t)ch * 384] = f2bf(xr); x[(size_t)ch * 384 + 64] = f2bf(xi);
                    const float nr = ar * xr - ai * xi + er[i], ni = ar * xi + ai * xr + ei[i]; xr = nr; xi = ni; } }
#pragma unroll
            for (int i = 0; i < 8; ++i) { er[i] = fr_[i]; ei[i] = fi_[i]; }
        }
    }
}

DI void hg_setup(KP p, int l, LAS unsigned char* L, bool valid, int row0, int clen, int h, int t2) {
    LAS float* cum = (LAS float*)(L + HG_CUM); LAS bf16_t* kraw = (LAS bf16_t*)(L + HG_KRAW); LAS bf16_t* vT = (LAS bf16_t*)(L + HG_VT);
    const bf16_t* zhg = (const bf16_t*)(p->ws + O_ZHG);
    {
        const int kc = t2 & 15;
        float lb[8];
#pragma unroll
        for (int i = 0; i < 8; ++i) lb[i] = 0.f;
        if (l == 1) { const float* lg = (const float*)p->in[19] + h * 128 + 8 * kc;
#pragma unroll
            for (int i = 0; i < 8; ++i) { const float x0 = lg[i], x1 = lg[512 + i]; const float mxx = fmaxf(x0, x1); const float e0 = __expf(x0 - mxx), e1 = __expf(x1 - mxx); lb[i] = e1 / (e0 + e1); } }
        u32x4 zw[4];
#pragma unroll
        for (int i = 0; i < 4; ++i) { const int s = (t2 >> 4) + 16 * i; zw[i] = (u32x4){0u, 0u, 0u, 0u};
            if (valid && s < clen) zw[i] = *(const u32x4*)(zhg + (size_t)(row0 + s) * 2048 + 512 + h * 128 + 8 * kc); }
        u32x4 vw[4];
#pragma unroll
        for (int i = 0; i < 4; ++i) { const int q = t2 + 256 * i, s = q & 63, vc = q >> 6; vw[i] = (u32x4){0u, 0u, 0u, 0u};
            if (valid && s < clen) vw[i] = *(const u32x4*)(zhg + (size_t)(row0 + s) * 2048 + 1024 + h * 128 + 8 * vc); }
#pragma unroll
        for (int i = 0; i < 4; ++i) {
            const int s = (t2 >> 4) + 16 * i; const bool in = valid && s < clen;
            const float z[8] = {bflo(zw[i].x), bfhi(zw[i].x), bflo(zw[i].y), bfhi(zw[i].y), bflo(zw[i].z), bfhi(zw[i].z), bflo(zw[i].w), bfhi(zw[i].w)};
            float lf[8], kk[8];
#pragma unroll
            for (int e = 0; e < 8; ++e) { const float sg = sigm(z[e]), f = lb[e] + (1.f - lb[e]) * sg; lf[e] = in ? __logf(fmaxf(f, 1e-6f)) : 0.f; kk[e] = in ? (1.f - lb[e]) * (1.f - sg) : 0.f; }
#pragma unroll
            for (int e = 0; e < 8; e += 2) *(LAS f32x2*)(cum + s * CUMP + 8 * kc + e) = (f32x2){lf[e], lf[e + 1]};
            u32x4 w; w.x = pk2(kk[0], kk[1]); w.y = pk2(kk[2], kk[3]); w.z = pk2(kk[4], kk[5]); w.w = pk2(kk[6], kk[7]);
            *(LAS u32x4*)(kraw + s * KRP + 8 * kc) = w;
        }
#pragma unroll
        for (int i = 0; i < 4; ++i) { const int q = t2 + 256 * i, s = q & 63, vc = q >> 6;
            const unsigned ww[4] = {vw[i].x, vw[i].y, vw[i].z, vw[i].w};
#pragma unroll
            for (int e = 0; e < 4; ++e) { vT[(8 * vc + 2 * e) * VTPP + s] = (bf16_t)(ww[e] & 0xffffu); vT[(8 * vc + 2 * e + 1) * VTPP + s] = (bf16_t)(ww[e] >> 16); } }
    }
    __syncthreads();
    if (t2 < 128) {
        float c = 0.f;
#pragma unroll 16
        for (int s = 0; s < 64; ++s) { c += cum[s * CUMP + t2]; cum[s * CUMP + t2] = c; }
    }
}
DI void hg_unit(int uidx, int& bh, int& c, int& row0, int& clen) { bh = uidx / HGC; c = uidx - bh * HGC; const int b = bh >> 2; row0 = b * LSEQ + (c == 0 ? 0 : 16 + 64 * (c - 1)); clen = c == 0 ? 16 : 64; }

DI void hg1_phase(KP p, int l, LAS unsigned char* lds) {
    p = kp_launder(p);
    const int tid = otid(), hw = tid >> 8, t2 = tid & 255, w4 = (tid >> 6) & 3, lane = tid & 63, fr = lane & 15, fq = lane >> 4;
    LAS unsigned char* L = lds + hw * HG_HALF;
    LAS float* cum = (LAS float*)(L + HG_CUM); LAS bf16_t* kraw = (LAS bf16_t*)(L + HG_KRAW); LAS bf16_t* vT = (LAS bf16_t*)(L + HG_VT);
    bf16_t* sloc = (bf16_t*)((unsigned char*)p->out + X_SLOC); float* dec = (float*)(p->ws + O_HGDEC);
    const int npairs = (64 * HGC + 1) / 2;
    for (int it = 0; it * (int)gridDim.x < npairs; ++it) {
        const int uidx = (it * gridDim.x + blockIdx.x) * 2 + hw; const bool valid = uidx < 64 * HGC;
        int bh, c, row0, clen; hg_unit(valid ? uidx : 0, bh, c, row0, clen); const int h = bh & 3;
        __syncthreads();
        hg_setup(p, l, L, valid, row0, clen, h, t2);
        __syncthreads();
        if (valid) {
            bf16x8 bfr[2][2];
#pragma unroll
            for (int nbi = 0; nbi < 2; ++nbi)
#pragma unroll
                for (int ks = 0; ks < 2; ++ks) {
                    const int dk = 16 * (2 * w4 + nbi) + fr; const float last = cum[63 * CUMP + dk]; float v[8];
#pragma unroll
                    for (int i = 0; i < 8; ++i) { const int s = 32 * ks + 8 * fq + i; v[i] = bf2f(kraw[s * KRP + dk]) * __expf(last - cum[s * CUMP + dk]); }
                    u32x4 w; w.x = pk2(v[0], v[1]); w.y = pk2(v[2], v[3]); w.z = pk2(v[4], v[5]); w.w = pk2(v[6], v[7]); bfr[nbi][ks] = __builtin_bit_cast(bf16x8, w);
                }
            bf16_t* dst = sloc + (size_t)(bh * HGC + c) * 128 * 128;
#pragma unroll
            for (int mb = 0; mb < 8; ++mb) {
                f32x4 a0 = {0.f, 0.f, 0.f, 0.f}, a1 = {0.f, 0.f, 0.f, 0.f};
#pragma unroll
                for (int ks = 0; ks < 2; ++ks) {
                    const bf16x8 af = *(const LAS bf16x8*)(vT + (16 * mb + fr) * VTPP + 32 * ks + 8 * fq);
                    a0 = __builtin_amdgcn_mfma_f32_16x16x32_bf16(af, bfr[0][ks], a0, 0, 0, 0);
                    a1 = __builtin_amdgcn_mfma_f32_16x16x32_bf16(af, bfr[1][ks], a1, 0, 0, 0);
                }
#pragma unroll
                for (int j = 0; j < 4; ++j) { const int dv = 16 * mb + 4 * fq + j;
                    dst[(size_t)dv * 128 + 16 * (2 * w4) + fr] = f2bf(a0[j]); dst[(size_t)dv * 128 + 16 * (2 * w4 + 1) + fr] = f2bf(a1[j]); }
            }
            if (t2 < 128) dec[(size_t)(bh * HGC + c) * 128 + t2] = __expf(cum[63 * CUMP + t2]);
        }
    }
    __syncthreads();
}

DI void hg2_phase(KP p, int gtid_, int gthreads) {
    p = kp_launder(p);
    const int gtid = blockIdx.x * 512 + otid(); gthreads = ogrid() * 512;
    bf16_t* sloc = (bf16_t*)((unsigned char*)p->out + X_SLOC); const float* dec = (const float*)(p->ws + O_HGDEC);
    for (int idx = gtid; idx < 64 * 128 * 16; idx += gthreads) {
        const int k8 = idx & 15, dv = (idx >> 4) & 127, bh = idx >> 11;
        float S[8];
#pragma unroll
        for (int i = 0; i < 8; ++i) S[i] = 0.f;
        bf16_t* base = sloc + ((size_t)(bh * HGC) * 128 + dv) * 128 + k8 * 8; const float* dbase = dec + (size_t)(bh * HGC) * 128 + k8 * 8;
        u32x4 wA[4], wB[4]; f32x4 dA[4][2], dB[4][2];
#pragma unroll
        for (int i = 0; i < 4; ++i) { wA[i] = *(const u32x4*)(base + (size_t)i * 16384); dA[i][0] = *(const f32x4*)(dbase + i * 128); dA[i][1] = *(const f32x4*)(dbase + i * 128 + 4); }
        for (int c0 = 0; c0 < HGC; c0 += 4) {
#pragma unroll
            for (int i = 0; i < 4; ++i) { const int c = c0 + 4 + i; if (c < HGC) { wB[i] = *(const u32x4*)(base + (size_t)c * 16384); dB[i][0] = *(const f32x4*)(dbase + c * 128); dB[i][1] = *(const f32x4*)(dbase + c * 128 + 4); } }
#pragma unroll
            for (int i = 0; i < 4; ++i) { const int c = c0 + i;
                if (c < HGC) {
                    u32x4 o; o.x = pk2(S[0], S[1]); o.y = pk2(S[2], S[3]); o.z = pk2(S[4], S[5]); o.w = pk2(S[6], S[7]);
                    *(u32x4*)(base + (size_t)c * 16384) = o;
                    const u32x4 w = wA[i]; const f32x4 d0 = dA[i][0], d1 = dA[i][1];
                    S[0] = d0[0] * S[0] + bflo(w.x); S[1] = d0[1] * S[1] + bfhi(w.x); S[2] = d0[2] * S[2] + bflo(w.y); S[3] = d0[3] * S[3] + bfhi(w.y);
                    S[4] = d1[0] * S[4] + bflo(w.z); S[5] = d1[1] * S[5] + bfhi(w.z); S[6] = d1[2] * S[6] + bflo(w.w); S[7] = d1[3] * S[7] + bfhi(w.w);
                } }
#pragma unroll
            for (int i = 0; i < 4; ++i) { wA[i] = wB[i]; dA[i][0] = dB[i][0]; dA[i][1] = dB[i][1]; }
        }
    }
}

DI void hg3_phase(KP p, int l, LAS unsigned char* lds) {
    p = kp_launder(p);
    const int tid = otid(), hw = tid >> 8, t2 = tid & 255, I = __builtin_amdgcn_readfirstlane((tid >> 6) & 3), lane = tid & 63, fr = lane & 15, fq = lane >> 4;
    LAS unsigned char* L = lds + hw * HG_HALF;
    LAS float* cum = (LAS float*)(L + HG_CUM); LAS bf16_t* kraw = (LAS bf16_t*)(L + HG_KRAW); LAS bf16_t* vT = (LAS bf16_t*)(L + HG_VT);
    const bf16_t* zhg = (const bf16_t*)(p->ws + O_ZHG); const bf16_t* st = (const bf16_t*)((unsigned char*)p->out + X_SLOC);
    bf16_t* hgout = (bf16_t*)(p->ws + O_HGOUT); const float* onorm = (const float*)p->in[20] + (size_t)l * 512;
    const int npairs = (64 * HGC + 1) / 2;
    for (int it = 0; it * (int)gridDim.x < npairs; ++it) {
        const int uidx = (it * gridDim.x + blockIdx.x) * 2 + hw; const bool valid = uidx < 64 * HGC;
        int bh, c, row0, clen; hg_unit(valid ? uidx : 0, bh, c, row0, clen); const int h = bh & 3;
        __syncthreads();
        hg_setup(p, l, L, valid, row0, clen, h, t2);
        __syncthreads();
        const int t = 16 * I + fr; const bool tv = valid && t < clen; const size_t row = (size_t)row0 + t;
        if (valid && 16 * I < clen) {
            bf16x8 qt[4], q2[4]; float Rr[4][8];
#pragma unroll
            for (int ks = 0; ks < 4; ++ks) {
                u32x4 qw = {0u, 0u, 0u, 0u}; if (tv) qw = *(const u32x4*)(zhg + row * 2048 + h * 128 + 32 * ks + 8 * fq);
                float q[8] = {bflo(qw.x), bfhi(qw.x), bflo(qw.y), bfhi(qw.y), bflo(qw.z), bfhi(qw.z), bflo(qw.w), bfhi(qw.w)};
                float a[8], bq[8];
#pragma unroll
                for (int i = 0; i < 8; ++i) { const int k = 32 * ks + 8 * fq + i; const float ct = cum[t * CUMP + k]; const float rr = I > 0 ? cum[(16 * I - 1) * CUMP + k] : 0.f; Rr[ks][i] = rr;
                    a[i] = q[i] * __expf(ct - rr); bq[i] = q[i] * __expf(ct); }
                u32x4 w; w.x = pk2(a[0], a[1]); w.y = pk2(a[2], a[3]); w.z = pk2(a[4], a[5]); w.w = pk2(a[6], a[7]); qt[ks] = __builtin_bit_cast(bf16x8, w);
                w.x = pk2(bq[0], bq[1]); w.y = pk2(bq[2], bq[3]); w.z = pk2(bq[4], bq[5]); w.w = pk2(bq[6], bq[7]); q2[ks] = __builtin_bit_cast(bf16x8, w);
            }
            f32x4 PT[4];
#pragma unroll
            for (int J = 0; J < 4; ++J) {
                PT[J] = (f32x4){0.f, 0.f, 0.f, 0.f};
                if (J <= I) {
#pragma unroll
                    for (int ks = 0; ks < 4; ++ks) {
                        const int s = 16 * J + fr; const u32x4 kw = *(const LAS u32x4*)(kraw + s * KRP + 32 * ks + 8 * fq);
                        float kk[8] = {bflo(kw.x), bfhi(kw.x), bflo(kw.y), bfhi(kw.y), bflo(kw.z), bfhi(kw.z), bflo(kw.w), bfhi(kw.w)};
#pragma unroll
                        for (int i = 0; i < 8; ++i) kk[i] *= __expf(Rr[ks][i] - cum[s * CUMP + 32 * ks + 8 * fq + i]);
                        u32x4 w; w.x = pk2(kk[0], kk[1]); w.y = pk2(kk[2], kk[3]); w.z = pk2(kk[4], kk[5]); w.w = pk2(kk[6], kk[7]);
                        PT[J] = __builtin_amdgcn_mfma_f32_16x16x32_bf16(__builtin_bit_cast(bf16x8, w), qt[ks], PT[J], 0, 0, 0);
                    }
                    if (J == I) {
#pragma unroll
                        for (int j = 0; j < 4; ++j) if (4 * fq + j > fr) PT[J][j] = 0.f;
                    }
                }
            }
            f32x4 acc[8];
#pragma unroll
            for (int mb = 0; mb < 8; ++mb) acc[mb] = (f32x4){0.f, 0.f, 0.f, 0.f};
#pragma unroll
            for (int pr = 0; pr < 2; ++pr) {
                const int J0 = 2 * pr;
                if (J0 <= I) {
                    u32x4 w; w.x = pk2(PT[J0][0], PT[J0][1]); w.y = pk2(PT[J0][2], PT[J0][3]); w.z = pk2(PT[J0 + 1][0], PT[J0 + 1][1]); w.w = pk2(PT[J0 + 1][2], PT[J0 + 1][3]);
                    const bf16x8 pf = __builtin_bit_cast(bf16x8, w);
#pragma unroll
                    for (int mb = 0; mb < 8; ++mb) {
                        const LAS bf16_t* vp = vT + (16 * mb + fr) * VTPP + 16 * J0 + 4 * fq;
                        const u32x2 lo = *(const LAS u32x2*)vp, hi = *(const LAS u32x2*)(vp + 16);
                        u32x4 a; a.x = lo.x; a.y = lo.y; a.z = hi.x; a.w = hi.y;
                        acc[mb] = __builtin_amdgcn_mfma_f32_16x16x32_bf16(__builtin_bit_cast(bf16x8, a), pf, acc[mb], 0, 0, 0);
                    }
                }
            }
            if (c > 0) {
                const bf16_t* sp = st + (size_t)(bh * HGC + c) * 128 * 128;
#pragma unroll
                for (int mb = 0; mb < 8; ++mb)
#pragma unroll
                    for (int ks = 0; ks < 4; ++ks) {
                        const bf16x8 af = *(const bf16x8*)(sp + (size_t)(16 * mb + fr) * 128 + 32 * ks + 8 * fq);
                        acc[mb] = __builtin_amdgcn_mfma_f32_16x16x32_bf16(af, q2[ks], acc[mb], 0, 0, 0);
                    }
            }
            float sq = 0.f;
#pragma unroll
            for (int mb = 0; mb < 8; ++mb) sq += acc[mb][0] * acc[mb][0] + acc[mb][1] * acc[mb][1] + acc[mb][2] * acc[mb][2] + acc[mb][3] * acc[mb][3];
            sq += __shfl_xor(sq, 16); sq += __shfl_xor(sq, 32);
            const float rs = rsqrtf(sq * (1.f / 128.f) + 1e-6f);
            if (tv) {
#pragma unroll
                for (int mb = 0; mb < 8; ++mb) {
                    const int dv = 16 * mb + 4 * fq;
                    const u32x2 gw = *(const u32x2*)(zhg + row * 2048 + 1536 + h * 128 + dv);
                    const f32x4 on = *(const f32x4*)(onorm + h * 128 + dv);
                    const float g0 = bflo(gw.x), g1 = bfhi(gw.x), g2 = bflo(gw.y), g3 = bfhi(gw.y);
                    u32x2 w; w.x = pk2(acc[mb][0] * rs * on[0] * g0 * sigm(g0), acc[mb][1] * rs * on[1] * g1 * sigm(g1));
                    w.y = pk2(acc[mb][2] * rs * on[2] * g2 * sigm(g2), acc[mb][3] * rs * on[3] * g3 * sigm(g3));
                    *(u32x2*)(hgout + row * 512 + h * 128 + dv) = w;
                }
            }
        }
    }
    __syncthreads();
}

#define XB_TMO      128
#define XB_XCNT(j)  (256  + 64 * (j))
#define XB_XSUB(j)  (1280 + 64 * (j))
#define XB_XGEN(j)  (2304 + 64 * (j))
#define XB_TOP      3328
#define XB_TOPGEN   3392
#define XCD_BAR_WORDS 3456
#define XB_SPIN_CAP (1u << 18)

__device__ __forceinline__ unsigned xb_ld(unsigned* p)              { return __hip_atomic_load(p, __ATOMIC_RELAXED, __HIP_MEMORY_SCOPE_AGENT); }
__device__ __forceinline__ unsigned xb_add(unsigned* p, unsigned v) { return __hip_atomic_fetch_add(p, v, __ATOMIC_RELAXED, __HIP_MEMORY_SCOPE_AGENT); }
__device__ __forceinline__ unsigned xb_xcc_id() { return (unsigned)__builtin_amdgcn_s_getreg((3 << 11) | 20) & 0xFu; }
#define XB_SPIN(cond, bar) do { unsigned _sp = 0; while (cond) { __builtin_amdgcn_s_sleep(1); \
    if ((++_sp & 255u) == 0u) { if (xb_ld(&(bar)[XB_TMO])) break; if (_sp > XB_SPIN_CAP) { atomicAdd(&(bar)[XB_TMO], 1u); break; } } } } while (0)

struct XcdBarrier {
    unsigned* bar; unsigned x;
    volatile LAS unsigned* st;
};

__device__ __forceinline__ XcdBarrier xcd_barrier_post(unsigned* bar, volatile LAS unsigned* st) {
    XcdBarrier b; b.bar = bar; b.x = xb_xcc_id(); b.st = st;
    if (threadIdx.x == 0) (void)xb_add(&bar[XB_XCNT(b.x)], 1u);
    return b;
}
__device__ __forceinline__ void xcd_barrier_complete(unsigned* bar, unsigned x, unsigned& nloc, unsigned& nx) {
    const unsigned G = gridDim.x * gridDim.y * gridDim.z;
    unsigned sum, cnt, mine, sp = 0u;
    for (;;) {
        sum = 0u; cnt = 0u; mine = 0u;
#pragma unroll
        for (unsigned j = 0; j < 16; ++j) { const unsigned c = xb_ld(&bar[XB_XCNT(j)]); sum += c; cnt += (c > 0u) ? 1u : 0u; mine = (j == x) ? c : mine; }
        if (sum == G) break;
        __builtin_amdgcn_s_sleep(1);
        if ((++sp & 255u) == 0u) { if (xb_ld(&bar[XB_TMO])) break; if (sp > XB_SPIN_CAP) { atomicAdd(&bar[XB_TMO], 1u); break; } }
    }
    nloc = mine > 0u ? mine : 1u; nx = cnt > 0u ? cnt : 1u;
}

__device__ __forceinline__ void xcd_barrier(const XcdBarrier& b) {
    asm volatile("s_waitcnt vmcnt(0)" ::: "memory");
    __syncthreads();
    if (threadIdx.x == 0) {
        unsigned* bar = b.bar;
        __builtin_amdgcn_s_waitcnt(0);
        unsigned nloc = b.st[0], nx = b.st[1];
        if (nloc == 0u) { xcd_barrier_complete(bar, b.x, nloc, nx); b.st[0] = nloc; b.st[1] = nx; }
        const unsigned old = xb_add(&bar[XB_XSUB(b.x)], 1u);
        const unsigned gen = old / nloc;
        if (old + 1u == (gen + 1u) * nloc) {
            __builtin_amdgcn_fence(__ATOMIC_RELEASE, "agent");
            asm volatile("s_waitcnt vmcnt(0)" ::: "memory");
            const unsigned og = xb_add(&bar[XB_TOP], 1u);
            const unsigned tg = og / nx;
            if (og + 1u == (tg + 1u) * nx) xb_add(&bar[XB_TOPGEN], 1u);
            else XB_SPIN(xb_ld(&bar[XB_TOPGEN]) == tg, bar);
            __builtin_amdgcn_fence(__ATOMIC_ACQUIRE, "agent");
            xb_add(&bar[XB_XGEN(b.x)], 1u);
            asm volatile("s_waitcnt vmcnt(0)" ::: "memory");
        } else {
            XB_SPIN(xb_ld(&bar[XB_XGEN(b.x)]) == gen, bar);
            __builtin_amdgcn_fence(__ATOMIC_ACQUIRE, "agent");
            asm volatile("s_waitcnt vmcnt(0)" ::: "memory");
        }
    }
    __syncthreads();
}


__global__ void __launch_bounds__(512, 2) fwd_megakernel(Params p_args) {
    KP p = kparams();
    extern __shared__ __attribute__((aligned(16))) unsigned char smem[];
    LAS unsigned char* lds = (LAS unsigned char*)smem;
    cg::grid_group grid = cg::this_grid();
    const int tid = threadIdx.x, wid = __builtin_amdgcn_readfirstlane(tid >> 6), lane = tid & 63;
    const int G = gridDim.x, c = blockIdx.x, gtid = c * 512 + tid, gthreads = G * 512, gwave = c * 8 + wid, nwaves = G * 8;
    unsigned char* ws = p->ws; unsigned char* xo = (unsigned char*)p->out;
    float* hres = (float*)(ws + O_HRES); float* ssq = (float*)(ws + O_SSQ);
    const float* cosT = (const float*)(ws + O_COS); const float* sinT = (const float*)(ws + O_SIN);

    if (c == 0) for (int i = tid; i < 4096; i += 512) __hip_atomic_store((unsigned*)(p->ws + O_BAR) + i, 0u, __ATOMIC_RELAXED, __HIP_MEMORY_SCOPE_AGENT);
    if (tid < 2) ((volatile LAS unsigned*)(lds + LDS_BARST))[tid] = 0u;
#if PH_PRO
    convert_weights(p, 0, 0, lds);
    convert_weights(p, 0, 1, lds);
    s5_build(p, 0, lds);
#endif
    ln_rows(p, 0, (const float*)p->in[3], (const float*)p->in[4], gwave, nwaves, lane);
    for (int idx = c * 512 + otid(); idx < T * 16; idx += ogrid() * 512) {
        const int r = idx >> 4, i = idx & 15, b = r / LSEQ, tt = r - b * LSEQ;
        const int pos = tt < 16 ? tt : ((const int*)p->in[1])[b * 2048 + tt - 16] + 16;
        const float inv = expf(-(float)i * (1.f / 16.f) * 9.210340371976184f);
        float s, cc; sincosf((float)pos * inv, &s, &cc);
        ((float*)(ws + O_COS))[idx] = cc; ((float*)(ws + O_SIN))[idx] = s;
    }
    for (int idx = c * 512 + otid(); idx < 2 * T; idx += ogrid() * 512) ssq[idx] = 0.f;
    for (int idx = c * 512 + otid(); idx < 8 * T; idx += ogrid() * 512) ((float*)(ws + O_STATS))[idx] = 0.f;
    grid.sync();
    const XcdBarrier xbar = xcd_barrier_post((unsigned*)(p->ws + O_BAR), (volatile LAS unsigned*)(lds + LDS_BARST));
#define WSP unsigned char* ws = kp_launder(p)->ws; unsigned char* xo = (unsigned char*)kp_launder(p)->out; (void)xo;
#define STATS(slot) ((float*)(ws + O_STATS) + (size_t)(slot) * T * 2)
#define COLV(off) ((const float*)(ws + O_COLV) + (off))

    for (int l = 0; l < 2; ++l) {
        { WSP
          pg8::SchedGrid S{(const char*)(ws + O_HBF), (const char*)(ws + W_WIN), 1024, 1024, 16, 129, 13, ogrid(), obid()};
          EpiA E{(bf16_t*)(xo + X_UG), (bf16_t*)(ws + O_ZHG), (bf16_t*)(ws + O_CQKV), (bf16_t*)(ws + O_KR), (float*)(ws + O_SSQ), (const float*)(ws + O_COS), (const float*)(ws + O_SIN),
                 l > 0 ? STATS(2 * l - 1) : (const float*)nullptr, COLV(CV_IN), COLV(CV_IN + 3328)};
          pg8::gemm_phase(lds, S, E);
          if (l == 1) convert_weights(p, 1, 1, lds); }
        xcd_barrier(xbar);
        { WSP
          EpiB E{(bf16_t*)(xo + X_QA), (bf16_t*)(ws + O_KA), (bf16_t*)(ws + O_VT), (float*)(ws + O_EBUF), (const float*)(ws + O_SSQ), (const float*)(ws + O_COS), (const float*)(ws + O_SIN)};
          pg8::gemm_phase(lds, SchedB{(const char*)(ws + O_CQKV), (const char*)(ws + W_WUQ), 512, 256, 4, 0, ogrid(), obid()}, E);
          pg8::gemm_phase(lds, SchedB{(const char*)(ws + O_CQKV) + 512, (const char*)(ws + W_WK), 512, 256, 4, 1, ogrid(), obid()}, E);
          pg8::gemm_phase(lds, SchedB{(const char*)(ws + W_WV), (const char*)(ws + O_CQKV) + 512, 256, 512, 4, 2, ogrid(), obid()}, E);
          pg8::gemm_phase(lds, SchedS5{(const char*)(xo + X_UG), (const char*)(ws + W_MB), 384, 256, 4, 3, ogrid(), obid()}, E); }
        xcd_barrier(xbar);
        if (otid() < 128) s5_scan(p, 0, G * 128);
        attention_phase(p, lds);
        { float* ssq = (float*)(kp_launder(p)->ws + O_SSQ); for (int idx = obid() * 512 + otid(); idx < 2 * T; idx += ogrid() * 512) ssq[idx] = 0.f; }
        xcd_barrier(xbar);
        { WSP
          pg8::gemm_phase(lds, SchedS5{(const char*)(xo + X_UG), (const char*)(ws + W_MD), 384, 384, 6, 0, ogrid(), obid()}, EpiS5Y{(bf16_t*)(ws + O_YGELU)}); }
        hg1_phase(p, l, lds);
        xcd_barrier(xbar);
        { WSP
          pg8::SchedGrid S{(const char*)(ws + O_YGELU), (const char*)(ws + W_WGLU), 512, 512, 8, 129, 2, ogrid(), obid()};
          pg8::gemm_phase(lds, S, EpiGlu{(const bf16_t*)(ws + O_YGELU), (bf16_t*)(ws + O_S5OUT)}); }
        hg2_phase(p, gtid, gthreads);
        xcd_barrier(xbar);
        hg3_phase(p, l, lds);
        xcd_barrier(xbar);
        { WSP
          EpiF E{(bf16_t*)(ws + O_GATEB), (bf16_t*)(ws + O_MIXED), l > 0 ? STATS(2 * l - 1) : (const float*)nullptr, COLV(CV_GATE), COLV(CV_GATE + 3072), (unsigned*)(ws + O_BAR) + 3520, 48u * (unsigned)l};
          const char* brp[3] = {(const char*)(ws + O_O), (const char*)(ws + O_S5OUT), (const char*)(ws + O_HGOUT)};
#pragma unroll
          for (int br = 0; br < 3; ++br) {
              pg8::gemm_phase(lds, SchedF{(const char*)(ws + O_HBF), (const char*)(ws + W_WGATE) + (size_t)br * 1024 * 1024 * 2, 1024, 1024, 16, 2 * br, ogrid(), obid()}, E);
              pg8::gemm_phase(lds, SchedF{brp[br], (const char*)(ws + W_WBR) + (size_t)br * 1024 * 512 * 2, 512, 512, 8, 2 * br + 1, ogrid(), obid()}, E);
          } }
        xcd_barrier(xbar);
        { WSP
          pg8::SchedGrid S{(const char*)(ws + O_MIXED), (const char*)(ws + W_WOUT), 1024, 1024, 16, 129, 4, ogrid(), obid()};
          EpiRes E{(bf16_t*)(ws + O_HBF), l > 0 ? STATS(2 * l - 1) : (const float*)nullptr, (const float*)kp_launder(p)->in[30] + (l - 1) * 1024, (const float*)kp_launder(p)->in[31] + (l - 1) * 1024, STATS(2 * l)};
          pg8::gemm_phase(lds, S, E); }
        xcd_barrier(xbar);
        { WSP
          pg8::SchedGrid S{(const char*)(ws + O_HBF), (const char*)(ws + W_WGU), 1024, 1024, 16, 129, 22, ogrid(), obid()};
          pg8::gemm_phase(lds, S, EpiFfn1{(bf16_t*)(ws + O_HFF), STATS(2 * l), COLV(CV_GU), COLV(CV_GU + 5632)});
          if (l == 0) { convert_weights(p, 1, 0, lds); s5_build(p, 1, lds); } }
        xcd_barrier(xbar);
        { WSP
          pg8::SchedGrid S{(const char*)(ws + O_HFF), (const char*)(ws + W_WD), DFF, DFF, 44, 129, 4, ogrid(), obid()};
          EpiRes E{(bf16_t*)(ws + O_HBF), STATS(2 * l), (const float*)kp_launder(p)->in[25] + l * 1024, (const float*)kp_launder(p)->in[26] + l * 1024, STATS(2 * l + 1)};
          pg8::gemm_phase(lds, S, E); }
        xcd_barrier(xbar);
    }
    ln_rows(p, 2, (const float*)p->in[30] + 1024, (const float*)p->in[31] + 1024, gwave, nwaves, lane);
}

extern "C" void kernel_launch(void* const* d_in, const int* in_sizes, int n_in, void* d_out, int out_size, void* d_ws, size_t ws_size, hipStream_t stream) {
    static int grid_blocks = 0;
    if (!grid_blocks) {
        int dev = 0, cus = 0, per_cu = 0;
        hipGetDevice(&dev);
        hipDeviceGetAttribute(&cus, hipDeviceAttributeMultiprocessorCount, dev);
        hipFuncSetAttribute((const void*)fwd_megakernel, hipFuncAttributeMaxDynamicSharedMemorySize, LDS_BYTES);
        hipOccupancyMaxActiveBlocksPerMultiprocessor(&per_cu, (const void*)fwd_megakernel, 512, LDS_BYTES);
        if (per_cu < 1) per_cu = 1;
        if (per_cu > 1) per_cu = 1;
        grid_blocks = cus * per_cu;
        if (ws_size < O_WSEND) fprintf(stderr, "kernel_launch: workspace too small: %zu < %zu\n", ws_size, (size_t)O_WSEND);
    }
    Params p{};
    for (int i = 0; i < 32; ++i) p.in[i] = d_in[i];
    p.out = (float*)d_out; p.ws = (unsigned char*)d_ws;
    void* args[] = {&p};
    hipError_t e = hipLaunchCooperativeKernel((const void*)fwd_megakernel, dim3(grid_blocks), dim3(512), args, LDS_BYTES, stream);
    if (e != hipSuccess) fprintf(stderr, "cooperative launch failed: %s (grid %d)\n", hipGetErrorString(e), grid_blocks);
}
```
